# Optimizing an MI355X kernel written in HIP

```python
import math
import jax, jax.numpy as jnp
from jax import lax
import numpy as np

D_MODEL = 1024
BATCH = 2
SEQ = 8192
DEPTH = 4

N_HEADS_A = 4
HD_A = 64
WIDTH_A = N_HEADS_A * 2 * HD_A
DIL_PAIRS = ((128, 1), (512, 4), (2048, 16))
N_DIL = len(DIL_PAIRS)
N_HEADS_B = 4
HD_B = 128
WIDTH_B = N_HEADS_B * HD_B
SSM_GROUP = 16
SSM_STATE = 64
WIDTH_C = 512
N_GROUPS_C = WIDTH_C // SSM_GROUP
N_BRANCHES = 3
A_QK_COLS = 2 * N_HEADS_A * HD_A
B_QKV_COLS = N_DIL * N_HEADS_B * HD_B
IN_SIZES = (A_QK_COLS, A_QK_COLS, WIDTH_A, B_QKV_COLS, B_QKV_COLS, B_QKV_COLS, WIDTH_C, N_BRANCHES * D_MODEL)
IN_COLS = sum(IN_SIZES)
D_FF = 2816
CONV_WIDTH = 3
ROPE_THETA = 500000.0
ROPE_FRACTION = 4
Q_BLOCK = 128
EPS = 1e-6

kernel_name = "hybrid_gated_diffattn_dilated_s5_convffn"


def rms_norm(x, g):
    xf = x.astype(jnp.float32)
    y = xf * lax.rsqrt(jnp.mean(xf * xf, axis=-1, keepdims=True) + EPS)
    return (y * g.astype(jnp.float32)).astype(x.dtype)


def rope_tables(positions, head_dim):
    rot = head_dim // ROPE_FRACTION
    inv = ROPE_THETA ** (-jnp.arange(0, rot, 2, dtype=jnp.float32) / rot)
    ang = positions.astype(jnp.float32)[..., None] * inv
    return jnp.cos(ang)[:, :, None, :], jnp.sin(ang)[:, :, None, :]


def apply_rope(x, cos, sin):
    half = cos.shape[-1]
    x1 = x[..., :half].astype(jnp.float32)
    x2 = x[..., half:2 * half].astype(jnp.float32)
    rot = jnp.concatenate([x1 * cos - x2 * sin, x2 * cos + x1 * sin], axis=-1).astype(x.dtype)
    return jnp.concatenate([rot, x[..., 2 * half:]], axis=-1)


def diff_attention(q, k, v, lam):
    bsz, s_len, h2, d = q.shape
    n_h = h2 // 2
    nb = s_len // Q_BLOCK
    scale = 1.0 / math.sqrt(d)
    qb = q.reshape(bsz, nb, Q_BLOCK, h2, d).transpose(1, 0, 2, 3, 4)
    starts = jnp.arange(nb) * Q_BLOCK
    kpos = jnp.arange(s_len)

    def one_block(args):
        qblk, st = args
        s = jnp.einsum('bqhd,bkhd->bhqk', qblk, k, preferred_element_type=jnp.float32) * scale
        mask = kpos[None, :] <= (st + jnp.arange(Q_BLOCK))[:, None]
        p = jax.nn.softmax(jnp.where(mask, s, -jnp.inf), axis=-1)
        p = p.reshape(bsz, n_h, 2, Q_BLOCK, s_len)
        a = p[:, :, 0] - lam * p[:, :, 1]
        return jnp.einsum('bhqk,bkhe->bqhe', a.astype(v.dtype), v)

    out = lax.map(one_block, (qb, starts))
    return out.transpose(1, 0, 2, 3, 4).reshape(bsz, s_len, n_h, 2 * d)


def dilated_window_attention(q, k, v, window, dilation):
    bsz, s_len, n_h, hd = q.shape
    blk = window // dilation
    unit = blk * dilation
    s_pad = -(-s_len // unit) * unit
    nb = s_pad // unit
    scale = 1.0 / math.sqrt(hd)

    def to_blocks(t):
        t = jnp.pad(t, ((0, 0), (0, s_pad - s_len), (0, 0), (0, 0)))
        return t.reshape(bsz, nb, blk, dilation, n_h, hd)

    qb, kb, vb = to_blocks(q), to_blocks(k), to_blocks(v)
    prev = lambda t: jnp.concatenate([jnp.zeros_like(t[:, :1]), t[:, :-1]], axis=1)
    kk = jnp.concatenate([prev(kb), kb], axis=2)
    vv = jnp.concatenate([prev(vb), vb], axis=2)
    s = jnp.einsum('bnqrhd,bnkrhd->bnrhqk', qb, kk, preferred_element_type=jnp.float32) * scale
    i = jnp.arange(blk)[:, None] + blk
    j = jnp.arange(2 * blk)[None, :]
    rel = i - j
    band = (rel >= 0) & (rel <= blk)
    has_prev = jnp.arange(nb)[:, None, None] > 0
    valid = band[None] & (has_prev | (j >= blk)[None])
    s = jnp.where(valid[None, :, None, None], s, -jnp.inf)
    m = jnp.max(s, axis=-1, keepdims=True)
    p = jnp.exp(s - m)
    den = jnp.sum(p, axis=-1, keepdims=True)
    o = jnp.einsum('bnrhqk,bnkrhd->bnqrhd', (p / den).astype(v.dtype), vv)
    lse = (m + jnp.log(den))[..., 0]
    o = o.reshape(bsz, s_pad, n_h, hd)[:, :s_len]
    lse = lse.transpose(0, 1, 4, 2, 3).reshape(bsz, s_pad, n_h)[:, :s_len]
    return o, lse


def _complex_scan_combine(e1, e2):
    a1r, a1i, b1r, b1i = e1
    a2r, a2i, b2r, b2i = e2
    return (a2r * a1r - a2i * a1i,
            a2r * a1i + a2i * a1r,
            a2r * b1r - a2i * b1i + b2r,
            a2r * b1i + a2i * b1r + b2i)


def s5_branch(u, a_re, a_im, log_dt, b_re, b_im, c_re, c_im, d_skip, w_glu, b_glu):
    bsz, s_len, _ = u.shape
    f32 = jnp.float32
    uf = u.astype(f32)
    ug = uf.reshape(bsz, s_len, N_GROUPS_C, SSM_GROUP)
    a_re, a_im = a_re.astype(f32), a_im.astype(f32)
    dt = jnp.exp(log_dt.astype(f32))[:, None]
    mag = jnp.exp(a_re * dt)
    lb_re, lb_im = mag * jnp.cos(a_im * dt), mag * jnp.sin(a_im * dt)
    n_re, n_im = lb_re - 1.0, lb_im
    den = a_re * a_re + a_im * a_im
    f_re = (n_re * a_re + n_im * a_im) / den
    f_im = (n_im * a_re - n_re * a_im) / den
    b_re, b_im = b_re.astype(f32), b_im.astype(f32)
    bb_re = f_re[..., None] * b_re - f_im[..., None] * b_im
    bb_im = f_re[..., None] * b_im + f_im[..., None] * b_re
    bu_re = jnp.einsum('gpc,bsgc->bsgp', bb_re, ug)
    bu_im = jnp.einsum('gpc,bsgc->bsgp', bb_im, ug)
    la_re = jnp.broadcast_to(lb_re, bu_re.shape)
    la_im = jnp.broadcast_to(lb_im, bu_re.shape)
    _, _, x_re, x_im = lax.associative_scan(_complex_scan_combine, (la_re, la_im, bu_re, bu_im), axis=1)
    y = (jnp.einsum('gcp,bsgp->bsgc', c_re.astype(f32), x_re)
         - jnp.einsum('gcp,bsgp->bsgc', c_im.astype(f32), x_im))
    y = y.reshape(bsz, s_len, WIDTH_C) + d_skip.astype(f32) * uf
    z = jax.nn.gelu(y).astype(u.dtype)
    return z * jax.nn.sigmoid(z @ w_glu + b_glu)


def conv_ffn(h, w_up, conv_w, conv_b, w_down):
    a, b = jnp.split(h @ w_up, 2, axis=-1)
    s_len = a.shape[1]
    ap = jnp.pad(a, ((0, 0), (CONV_WIDTH - 1, 0), (0, 0)))
    a = conv_b + sum(conv_w[j] * ap[:, j:j + s_len] for j in range(CONV_WIDTH))
    return (jax.nn.silu(a) * b) @ w_down


def setup_inputs(seed: int = 0) -> dict:
    key = jax.random.key(seed)
    ks = iter(jax.random.split(key, 40))
    f32 = jnp.float32
    L = DEPTH
    nrm = lambda shape, scale: scale * jax.random.normal(next(ks), shape, f32)
    gain = lambda shape: 1.0 + 0.02 * jax.random.normal(next(ks), shape, f32)
    state_idx = jnp.arange(SSM_STATE, dtype=f32)
    return {
        "x": jax.random.normal(next(ks), (BATCH, SEQ, D_MODEL), f32),
        "positions": jnp.broadcast_to(jnp.arange(SEQ, dtype=jnp.int32), (BATCH, SEQ)),
        "attn_norm_g": gain((L, D_MODEL)),
        "w_in": nrm((L, D_MODEL, IN_COLS), D_MODEL ** -0.5),
        "b_gate": nrm((L, N_BRANCHES * D_MODEL), 0.01),
        "qn_a": gain((L, HD_A)),
        "kn_a": gain((L, HD_A)),
        "lam_q1": nrm((L, HD_A), 0.1),
        "lam_k1": nrm((L, HD_A), 0.1),
        "lam_q2": nrm((L, HD_A), 0.1),
        "lam_k2": nrm((L, HD_A), 0.1),
        "subln_g": gain((L, 2 * HD_A)),
        "w_br_a": nrm((L, WIDTH_A, D_MODEL), WIDTH_A ** -0.5),
        "qn_b": gain((L, HD_B)),
        "kn_b": gain((L, HD_B)),
        "w_br_b": nrm((L, WIDTH_B, D_MODEL), WIDTH_B ** -0.5),
        "ssm_a_re": -0.5 + nrm((L, N_GROUPS_C, SSM_STATE), 0.01),
        "ssm_a_im": jnp.pi * state_idx + nrm((L, N_GROUPS_C, SSM_STATE), 0.01),
        "ssm_log_dt": jax.random.uniform(next(ks), (L, N_GROUPS_C), f32, math.log(1e-3), math.log(1e-1)),
        "ssm_b_re": nrm((L, N_GROUPS_C, SSM_STATE, SSM_GROUP), (2 * SSM_GROUP) ** -0.5),
        "ssm_b_im": nrm((L, N_GROUPS_C, SSM_STATE, SSM_GROUP), (2 * SSM_GROUP) ** -0.5),
        "ssm_c_re": nrm((L, N_GROUPS_C, SSM_GROUP, SSM_STATE), (2 * SSM_STATE) ** -0.5),
        "ssm_c_im": nrm((L, N_GROUPS_C, SSM_GROUP, SSM_STATE), (2 * SSM_STATE) ** -0.5),
        "ssm_d": nrm((L, WIDTH_C), 1.0),
        "w_glu": nrm((L, WIDTH_C, WIDTH_C), WIDTH_C ** -0.5),
        "b_glu": nrm((L, WIDTH_C), 0.01),
        "w_br_c": nrm((L, WIDTH_C, D_MODEL), WIDTH_C ** -0.5),
        "w_out": nrm((L, D_MODEL, D_MODEL), D_MODEL ** -0.5),
        "ffn_norm_g": gain((L, D_MODEL)),
        "w_up": nrm((L, D_MODEL, 2 * D_FF), D_MODEL ** -0.5),
        "conv_w": nrm((L, CONV_WIDTH, D_FF), CONV_WIDTH ** -0.5),
        "conv_b": nrm((L, D_FF), 0.01),
        "w_down": nrm((L, D_FF, D_MODEL), D_FF ** -0.5),
    }


def reference(x, positions, attn_norm_g, w_in, b_gate, qn_a, kn_a, lam_q1, lam_k1, lam_q2, lam_k2,
              subln_g, w_br_a, qn_b, kn_b, w_br_b, ssm_a_re, ssm_a_im, ssm_log_dt, ssm_b_re, ssm_b_im,
              ssm_c_re, ssm_c_im, ssm_d, w_glu, b_glu, w_br_c, w_out, ffn_norm_g, w_up, conv_w, conv_b,
              w_down):
    bsz, s_len, _ = x.shape
    split_idx = np.cumsum(IN_SIZES)[:-1].tolist()
    cos_a, sin_a = rope_tables(positions, HD_A)
    cos_b, sin_b = rope_tables(positions, HD_B)
    for l in range(DEPTH):
        h = rms_norm(x, attn_norm_g[l])
        proj = h @ w_in[l]
        a_q, a_k, a_v, b_q, b_k, b_v, c_u, gates = jnp.split(proj, split_idx, axis=-1)

        qa = apply_rope(rms_norm(a_q.reshape(bsz, s_len, 2 * N_HEADS_A, HD_A), qn_a[l]), cos_a, sin_a)
        ka = apply_rope(rms_norm(a_k.reshape(bsz, s_len, 2 * N_HEADS_A, HD_A), kn_a[l]), cos_a, sin_a)
        va = a_v.reshape(bsz, s_len, N_HEADS_A, 2 * HD_A)
        lam_init = 0.8 - 0.6 * math.exp(-0.3 * l)
        lam = (jnp.exp(jnp.sum(lam_q1[l].astype(jnp.float32) * lam_k1[l].astype(jnp.float32)))
               - jnp.exp(jnp.sum(lam_q2[l].astype(jnp.float32) * lam_k2[l].astype(jnp.float32)))
               + lam_init)
        oa = diff_attention(qa, ka, va, lam)
        oa = (rms_norm(oa, subln_g[l]) * (1.0 - lam_init)).reshape(bsz, s_len, WIDTH_A)

        qb = apply_rope(rms_norm(b_q.reshape(bsz, s_len, N_DIL * N_HEADS_B, HD_B), qn_b[l]), cos_b, sin_b)
        kb = apply_rope(rms_norm(b_k.reshape(bsz, s_len, N_DIL * N_HEADS_B, HD_B), kn_b[l]), cos_b, sin_b)
        qb = qb.reshape(bsz, s_len, N_DIL, N_HEADS_B, HD_B)
        kb = kb.reshape(bsz, s_len, N_DIL, N_HEADS_B, HD_B)
        vb = b_v.reshape(bsz, s_len, N_DIL, N_HEADS_B, HD_B)
        outs, lses = [], []
        for g, (window, dilation) in enumerate(DIL_PAIRS):
            o_g, lse_g = dilated_window_attention(qb[:, :, g], kb[:, :, g], vb[:, :, g], window, dilation)
            outs.append(o_g)
            lses.append(lse_g)
        wts = jax.nn.softmax(jnp.stack(lses, axis=0), axis=0)
        ob = jnp.einsum('gbsh,gbshd->bshd', wts, jnp.stack(outs, axis=0).astype(jnp.float32))
        ob = ob.astype(x.dtype).reshape(bsz, s_len, WIDTH_B)

        oc = s5_branch(c_u, ssm_a_re[l], ssm_a_im[l], ssm_log_dt[l], ssm_b_re[l], ssm_b_im[l],
                       ssm_c_re[l], ssm_c_im[l], ssm_d[l], w_glu[l], b_glu[l])

        g = jax.nn.sigmoid((gates + b_gate[l]).reshape(bsz, s_len, N_BRANCHES, D_MODEL))
        merged = (g[:, :, 0] * (oa @ w_br_a[l]) + g[:, :, 1] * (ob @ w_br_b[l])
                  + g[:, :, 2] * (oc @ w_br_c[l]))
        x = x + merged @ w_out[l]

        x = x + conv_ffn(rms_norm(x, ffn_norm_g[l]), w_up[l], conv_w[l], conv_b[l], w_down[l])
    return x
```

```cpp
#include <hip/hip_runtime.h>
#include <hip/hip_cooperative_groups.h>
#include <cstdio>
#include <cstdint>
namespace pg8 {
#define PG8_LAS __attribute__((address_space(3)))
typedef unsigned short bf16_t;
typedef short bf16x8 __attribute__((ext_vector_type(8)));
typedef float f32x4 __attribute__((ext_vector_type(4)));
typedef unsigned u32x4 __attribute__((ext_vector_type(4)));
constexpr int BM = 256, BK = 64, HALF = 128, HTB = HALF * BK * 2  , STAGE_BYTES = 8 * HTB, NXCD = 8, WGM = 8;

__host__ __device__ __forceinline__ int lds_byte(int r, int c) { const int st = (r >> 4) * 2 + (c >> 5), rr = r & 15, cc = c & 31, ob = rr * 64 + cc * 2; return st * 1024 + (ob ^ (((ob >> 9) & 1) << 5)); }
__host__ __device__ __forceinline__ void stage_rc(int b, int& R, int& C) { const int st = b / 1024, sb = b % 1024, swz = sb ^ (((sb >> 9) & 1) << 5); R = (st >> 1) * 16 + swz / 64; C = (st & 1) * 32 + (swz % 64) / 2; }
__host__ __device__ __forceinline__ int perm32(int rho) { const int n = rho >> 4, i = rho & 15; return 8 * (i >> 2) + 4 * n + (i & 3); }


typedef unsigned u32x2 __attribute__((ext_vector_type(2)));
struct Unit { int pm, pn, g; };
struct Gemm { const char* A; const char* Bt; int K; int a_row, a_c16, a_kt; };

struct StaticOrder {
    int nM, nN, nwg, G, c; size_t ta, tb;
    __device__ void init(int M, int N, int G_, int c_, size_t ta_, size_t tb_) { nM = M / BM; nN = N / BM; nwg = nM * nN; G = G_; c = c_; ta = ta_; tb = tb_; }
    __device__ void init_tiles(int nM_, int nN_, int G_, int c_, size_t ta_, size_t tb_) { nM = nM_; nN = nN_; nwg = nM * nN; G = G_; c = c_; ta = ta_; tb = tb_; }
    __device__ bool next(int i, Unit& u) const {
        const long L = (long)i * G + c; if (L >= nwg) return false;
        int wgid = (int)L; { const int q = nwg / NXCD, r = nwg % NXCD, xcd = wgid % NXCD, off = wgid / NXCD; wgid = (xcd < r ? xcd * (q + 1) : r * (q + 1) + (xcd - r) * q) + off; }
        const int nig = WGM * nN, gid = wgid / nig, fm = gid * WGM, gsz = (nM - fm) < WGM ? (nM - fm) : WGM;
        u.pm = fm + ((wgid % nig) % gsz); u.pn = (wgid % nig) / gsz; u.g = 0; return true;
    }
    __device__ __forceinline__ size_t offA(const Unit& u) const { return (size_t)u.pm * ta; }
    __device__ __forceinline__ size_t offB(const Unit& u) const { return (size_t)u.pn * tb; }
};
struct GroupOrder {
    int nM, nN, nwg, G, c; size_t ta, tb, ga, gb;
    __device__ void init(int nM_, int nN_, int G_, int c_, size_t ta_, size_t tb_, size_t ga_, size_t gb_) { nM = nM_; nN = nN_; nwg = 32 * nM_ * nN_; G = G_; c = c_; ta = ta_; tb = tb_; ga = ga_; gb = gb_; }
    __device__ bool next(int i, Unit& u) const {
        const long L = (long)i * G + c; if (L >= nwg) return false;
        const int per = nM * nN, g = (int)L / per, r = (int)L % per; u.g = g; u.pm = r / nN; u.pn = r % nN; return true;
    }
    __device__ __forceinline__ size_t offA(const Unit& u) const { return (size_t)u.g * ga + (size_t)u.pm * ta; }
    __device__ __forceinline__ size_t offB(const Unit& u) const { return (size_t)u.g * gb + (size_t)u.pn * tb; }
};

typedef float f32x2cv __attribute__((ext_vector_type(2))); typedef __bf16 bf16x2cv __attribute__((ext_vector_type(2)));
__device__ __forceinline__ unsigned cvt_pk_bf16(float lo, float hi) { f32x2cv v = {lo, hi}; bf16x2cv b = __builtin_convertvector(v, bf16x2cv); return __builtin_bit_cast(unsigned, b); }
__device__ __forceinline__ float shx(float v, int mask, int lane) { return __int_as_float(__builtin_amdgcn_ds_bpermute((lane ^ mask) << 2, __float_as_int(v))); }
__device__ __forceinline__ float bflo(unsigned w) { return __uint_as_float(w << 16); }
__device__ __forceinline__ float bfhi(unsigned w) { return __uint_as_float(w & 0xffff0000u); }
__device__ __forceinline__ float sigmoidf_(float x) { return __builtin_amdgcn_rcpf(1.0f + __builtin_amdgcn_exp2f(-1.4426950408889634f * x)); }
__device__ __forceinline__ float gelu_tanh(float v) { const float a = 0.7978845608028654f * (v + 0.044715f * v * v * v); const float t = 1.0f - 2.0f * __builtin_amdgcn_rcpf(1.0f + __builtin_amdgcn_exp2f(2.0f * 1.4426950408889634f * a)); return 0.5f * v * (1.0f + t); }
__device__ __forceinline__ u32x4 pack8(const f32x4 a, const f32x4 b) { u32x4 w; w.x = cvt_pk_bf16(a[0], a[1]); w.y = cvt_pk_bf16(a[2], a[3]); w.z = cvt_pk_bf16(b[0], b[1]); w.w = cvt_pk_bf16(b[2], b[3]); return w; }
__device__ __forceinline__ void unpack8(const u32x4 w, f32x4& a, f32x4& b) { a = (f32x4){bflo(w.x), bfhi(w.x), bflo(w.y), bfhi(w.y)}; b = (f32x4){bflo(w.z), bfhi(w.z), bflo(w.w), bfhi(w.w)}; }

#define EPI_ROWS_BEGIN _Pragma("unroll") for (int ai = 0; ai < 2; ++ai) _Pragma("unroll") for (int m = 0; m < 4; ++m) { const int rt = ai * 128 + wr * 64 + m * 16 + fr; const int row = u.pm * 256 + rt; (void)row;
#define EPI_ROWS_END asm volatile("" ::: "memory"); }

__device__ __forceinline__ void row_rstd(float (&rs)[8], const float* ssq, const Unit& u, int wr, int fr) {
    f32x4 q[8];
#pragma unroll
    for (int i = 0; i < 8; ++i) q[i] = *(const f32x4*)(ssq + (size_t)(u.pm * 256 + (i >> 2) * 128 + wr * 64 + (i & 3) * 16 + fr) * 4);
#pragma unroll
    for (int i = 0; i < 8; ++i) rs[i] = __builtin_amdgcn_rsqf(((q[i][0] + q[i][1]) + (q[i][2] + q[i][3])) * (1.0f / 1024.0f) + 1e-6f);
}
struct EpiInProj {
    static constexpr bool PERM = true, HOOK = false, PRE = true;
    bf16_t *qa, *ka, *va, *qb, *kb, *vb, *cu, *gates;
    const float *qn_a, *kn_a, *qn_b, *kn_b, *b_gate, *ropeA, *ropeB;
    PG8_LAS float* xch;
    const float* ssq;
    __device__ __forceinline__ void plain(const f32x4 (&acc)[2][2][4][2], const float (&rsr)[8], const Unit& u, int wr, int wc, int fr, int fq, bf16_t* dst, int ld, int tl) const {
        EPI_ROWS_BEGIN
#pragma unroll
            for (int bj = 0; bj < 2; ++bj) *(u32x4*)(dst + (size_t)row * ld + tl * 256 + bj * 128 + wc * 32 + 8 * fq) = pack8(acc[ai][bj][m][0] * rsr[ai * 4 + m], acc[ai][bj][m][1] * rsr[ai * 4 + m]);
        EPI_ROWS_END
    }
    __device__ __forceinline__ void plain_va(const f32x4 (&acc)[2][2][4][2], const float (&rsr)[8], const Unit& u, int wr, int wc, int fr, int fq, int tl) const {
        EPI_ROWS_BEGIN
#pragma unroll
            for (int bj = 0; bj < 2; ++bj) { const int col = tl * 256 + bj * 128 + wc * 32 + 8 * fq;
                *(u32x4*)(va + ((size_t)(col >> 7) * 16384 + row) * 128 + (col & 127)) = pack8(acc[ai][bj][m][0] * rsr[ai * 4 + m], acc[ai][bj][m][1] * rsr[ai * 4 + m]); }
        EPI_ROWS_END
    }
    __device__ __forceinline__ void plain_cu(const f32x4 (&acc)[2][2][4][2], const float (&rsr)[8], const Unit& u, int wr, int wc, int fr, int fq, int tl) const {
        EPI_ROWS_BEGIN
#pragma unroll
            for (int bj = 0; bj < 2; ++bj) { const int col = tl * 256 + bj * 128 + wc * 32 + 8 * fq;
                *(u32x4*)(cu + ((size_t)(col >> 4) * 16384 + row) * 16 + (col & 15)) = pack8(acc[ai][bj][m][0] * rsr[ai * 4 + m], acc[ai][bj][m][1] * rsr[ai * 4 + m]); }
        EPI_ROWS_END
    }
    __device__ __forceinline__ void gate(const f32x4 (&acc)[2][2][4][2], const float (&rsr)[8], const Unit& u, int wr, int wc, int fr, int fq, int tl) const {
        f32x4 bv[2][2];
#pragma unroll
        for (int bj = 0; bj < 2; ++bj) { const float* bp = b_gate + tl * 256 + bj * 128 + wc * 32 + 8 * fq; bv[bj][0] = *(const f32x4*)bp; bv[bj][1] = *(const f32x4*)(bp + 4); }
        EPI_ROWS_BEGIN
#pragma unroll
            for (int bj = 0; bj < 2; ++bj) { f32x4 a = acc[ai][bj][m][0] * rsr[ai * 4 + m] + bv[bj][0], b = acc[ai][bj][m][1] * rsr[ai * 4 + m] + bv[bj][1];
#pragma unroll
                for (int e = 0; e < 4; ++e) { a[e] = sigmoidf_(a[e]); b[e] = sigmoidf_(b[e]); }
                *(u32x4*)(gates + (size_t)row * 3072 + tl * 256 + bj * 128 + wc * 32 + 8 * fq) = pack8(a, b); }
        EPI_ROWS_END
    }
    __device__ __forceinline__ void norm64(const f32x4 (&acc)[2][2][4][2], const float (&rsr)[8], const Unit& u, int wr, int wc, int fr, int fq, bf16_t* dst, const float* gain, float qs, int tl) const {
        f32x4 g00, g01, g10, g11;
        g00 = (f32x4){gain[2 * fq], gain[2 * fq + 1], gain[8 + 2 * fq], gain[9 + 2 * fq]};
        g01 = *(const f32x4*)(gain + 16 + 4 * fq); g10 = *(const f32x4*)(gain + 32 + 8 * fq); g11 = *(const f32x4*)(gain + 36 + 8 * fq);
        g00 *= qs; g01 *= qs; g10 *= qs; g11 *= qs;
        EPI_ROWS_BEGIN
            const float rw = rsr[ai * 4 + m]; f32x4 v00 = acc[ai][0][m][0] * rw, v01 = acc[ai][0][m][1] * rw, v10 = acc[ai][1][m][0] * rw, v11 = acc[ai][1][m][1] * rw;
            float ss = 0.f;
#pragma unroll
            for (int e = 0; e < 4; ++e) ss += v00[e] * v00[e] + v01[e] * v01[e] + v10[e] * v10[e] + v11[e] * v11[e];
            ss += shx(ss, 16, fq * 16 + fr); ss += shx(ss, 32, fq * 16 + fr);
            const float rs = __builtin_amdgcn_rsqf(ss * (1.0f / 64.0f) + 1e-6f);
            v00 = v00 * rs * g00; v01 = v01 * rs * g01; v10 = v10 * rs * g10; v11 = v11 * rs * g11;
            const f32x4 cs = *(const f32x4*)(ropeA + (size_t)row * 16 + 4 * fq);
            const float o0 = v00[0] * cs[0] - v00[2] * cs[1], o2 = v00[2] * cs[0] + v00[0] * cs[1];
            const float o1 = v00[1] * cs[2] - v00[3] * cs[3], o3 = v00[3] * cs[2] + v00[1] * cs[3];
            bf16_t* base = dst + ((size_t)(tl * 4 + wc) * 16384 + row) * 64;
            *(unsigned*)(base + 2 * fq) = cvt_pk_bf16(o0, o1);
            *(unsigned*)(base + 8 + 2 * fq) = cvt_pk_bf16(o2, o3);
            u32x2 w2; w2.x = cvt_pk_bf16(v01[0], v01[1]); w2.y = cvt_pk_bf16(v01[2], v01[3]);
            *(u32x2*)(base + 16 + 4 * fq) = w2;
            *(u32x4*)(base + 32 + 8 * fq) = pack8(v10, v11);
        EPI_ROWS_END
    }
    __device__ __forceinline__ void norm128(const f32x4 (&acc)[2][2][4][2], const float (&rsr)[8], const Unit& u, int wr, int wc, int fr, int fq, bf16_t* dst, const float* gain, float qs, int tl) const {
        const int w = wc & 1, head = wc >> 1;
        const int d00 = w ? 64 + 8 * fq : 4 * fq, d01 = w ? 68 + 8 * fq : 16 + 4 * fq, d1 = w ? 96 + 8 * fq : 32 + 8 * fq;
        f32x4 g00 = *(const f32x4*)(gain + d00), g01 = *(const f32x4*)(gain + d01), g10 = *(const f32x4*)(gain + d1), g11 = *(const f32x4*)(gain + d1 + 4);
        g00 *= qs; g01 *= qs; g10 *= qs; g11 *= qs;
        float ssr[8];
        EPI_ROWS_BEGIN
            const float rw = rsr[ai * 4 + m]; const f32x4 v00 = acc[ai][0][m][0] * rw, v01 = acc[ai][0][m][1] * rw, v10 = acc[ai][1][m][0] * rw, v11 = acc[ai][1][m][1] * rw;
            float ss = 0.f;
#pragma unroll
            for (int e = 0; e < 4; ++e) ss += v00[e] * v00[e] + v01[e] * v01[e] + v10[e] * v10[e] + v11[e] * v11[e];
            ss += shx(ss, 16, fq * 16 + fr); ss += shx(ss, 32, fq * 16 + fr);
            ssr[ai * 4 + m] = ss;
            if (fq == 0) xch[rt * 4 + wc] = ss;
        EPI_ROWS_END
        asm volatile("s_waitcnt lgkmcnt(0)" ::: "memory"); __builtin_amdgcn_s_barrier(); asm volatile("" ::: "memory");
        EPI_ROWS_BEGIN
            const float rw = rsr[ai * 4 + m]; f32x4 v00 = acc[ai][0][m][0] * rw, v01 = acc[ai][0][m][1] * rw, v10 = acc[ai][1][m][0] * rw, v11 = acc[ai][1][m][1] * rw;
            const float tot = ssr[ai * 4 + m] + xch[rt * 4 + (wc ^ 1)];
            const float rs = __builtin_amdgcn_rsqf(tot * (1.0f / 128.0f) + 1e-6f);
            v00 = v00 * rs * g00; v01 = v01 * rs * g01; v10 = v10 * rs * g10; v11 = v11 * rs * g11;
            if (w == 0) {
                const f32x4 c0 = *(const f32x4*)(ropeB + (size_t)row * 32 + 8 * fq), c1 = *(const f32x4*)(ropeB + (size_t)row * 32 + 8 * fq + 4);
                const float cc[4] = {c0[0], c0[2], c1[0], c1[2]}, sn[4] = {c0[1], c0[3], c1[1], c1[3]};
#pragma unroll
                for (int e = 0; e < 4; ++e) { const float x1 = v00[e], x2 = v01[e]; v00[e] = x1 * cc[e] - x2 * sn[e]; v01[e] = x2 * cc[e] + x1 * sn[e]; }
            }
            bf16_t* base = dst + (size_t)row * 1536 + tl * 256 + head * 128;
            u32x2 a2; a2.x = cvt_pk_bf16(v00[0], v00[1]); a2.y = cvt_pk_bf16(v00[2], v00[3]); *(u32x2*)(base + d00) = a2;
            u32x2 b2; b2.x = cvt_pk_bf16(v01[0], v01[1]); b2.y = cvt_pk_bf16(v01[2], v01[3]); *(u32x2*)(base + d01) = b2;
            *(u32x4*)(base + d1) = pack8(v10, v11);
        EPI_ROWS_END
    }
    __device__ __forceinline__ void prefetch(f32x4 (&q)[8], const Unit& u, int wr, int fr) const {
#pragma unroll
        for (int i = 0; i < 8; ++i) q[i] = *(const f32x4*)(ssq + (size_t)(u.pm * 256 + (i >> 2) * 128 + wr * 64 + (i & 3) * 16 + fr) * 4);
    }
    __device__ __forceinline__ void run(const f32x4 (&acc)[2][2][4][2], const f32x4 (&q)[8], const Unit& u, int wr, int wc, int fr, int fq) const {
        const int pn = u.pn; float rsr[8];
#pragma unroll
        for (int i = 0; i < 8; ++i) rsr[i] = __builtin_amdgcn_rsqf(((q[i][0] + q[i][1]) + (q[i][2] + q[i][3])) * (1.0f / 1024.0f) + 1e-6f);
        if (pn < 2) norm64(acc, rsr, u, wr, wc, fr, fq, qa, qn_a, 0.125f * 1.4426950408889634f, pn);
        else if (pn < 4) norm64(acc, rsr, u, wr, wc, fr, fq, ka, kn_a, 1.0f, pn - 2);
        else if (pn < 6) plain_va(acc, rsr, u, wr, wc, fr, fq, pn - 4);
        else if (pn < 12) norm128(acc, rsr, u, wr, wc, fr, fq, qb, qn_b, 0.08838834764831845f * 1.4426950408889634f, pn - 6);
        else if (pn < 18) norm128(acc, rsr, u, wr, wc, fr, fq, kb, kn_b, 1.0f, pn - 12);
        else if (pn < 24) plain(acc, rsr, u, wr, wc, fr, fq, vb, 1536, pn - 18);
        else if (pn < 26) plain_cu(acc, rsr, u, wr, wc, fr, fq, pn - 24);
        else gate(acc, rsr, u, wr, wc, fr, fq, pn - 26);
    }
};

struct EpiSsm1 {
    static constexpr bool PERM = true, HOOK = false, PRE = false;
    bf16_t* y; float* E;
    __device__ __forceinline__ void operator()(const f32x4 (&acc)[2][2][4][2], const Unit& u, int wr, int wc, int fr, int fq) const {
        const int g = u.g;
        if (u.pn < 2) {
            EPI_ROWS_BEGIN
#pragma unroll
                for (int bj = 0; bj < 2; ++bj) { const int nidx = u.pn * 256 + bj * 128 + wc * 32 + 8 * fq, t = nidx >> 4, c = nidx & 15;
                    *(u32x4*)(y + ((size_t)g * 16384 + (size_t)row * 32 + t) * 16 + c) = pack8(acc[ai][bj][m][0], acc[ai][bj][m][1]); }
            EPI_ROWS_END
        } else {
            EPI_ROWS_BEGIN
                float* p = E + ((size_t)g * 512 + row) * 128 + wc * 32 + 8 * fq; *(f32x4*)p = acc[ai][0][m][0]; *(f32x4*)(p + 4) = acc[ai][0][m][1];
            EPI_ROWS_END
        }
    }
};
struct EpiSsm2 {
    static constexpr bool PERM = true, HOOK = false, PRE = false;
    const bf16_t* y; const bf16_t* cu; const float* dsk; bf16_t* z;
    __device__ __forceinline__ void operator()(const f32x4 (&acc)[2][2][4][2], const Unit& u, int wr, int wc, int fr, int fq) const {
        const int g = u.g;
        EPI_ROWS_BEGIN
#pragma unroll
            for (int bj = 0; bj < 2; ++bj) { const int nidx = u.pn * 256 + bj * 128 + wc * 32 + 8 * fq, t = nidx >> 4, c = nidx & 15;
                const size_t off = ((size_t)row * 32 + t) * 512 + 16 * g + c, offg = ((size_t)g * 16384 + (size_t)row * 32 + t) * 16 + c;
                f32x4 ya, yb; unpack8(*(const u32x4*)(y + offg), ya, yb); f32x4 a = acc[ai][bj][m][0] + ya, b = acc[ai][bj][m][1] + yb;
                f32x4 ua, ub; unpack8(*(const u32x4*)(cu + offg), ua, ub);
                a += ua * *(const f32x4*)(dsk + 16 * g + c); b += ub * *(const f32x4*)(dsk + 16 * g + c + 4);
#pragma unroll
                for (int e = 0; e < 4; ++e) { a[e] = gelu_tanh(a[e]); b[e] = gelu_tanh(b[e]); }
                *(u32x4*)(z + off) = pack8(a, b); asm volatile("" ::: "memory"); }
        EPI_ROWS_END
    }
};
struct EpiGlu {
    static constexpr bool PERM = true, HOOK = false, PRE = false;
    const bf16_t* z; const float* bias; bf16_t* oc; int ldo;
    __device__ __forceinline__ void operator()(const f32x4 (&acc)[2][2][4][2], const Unit& u, int wr, int wc, int fr, int fq) const {
        EPI_ROWS_BEGIN
#pragma unroll
            for (int bj = 0; bj < 2; ++bj) { const int col = u.pn * 256 + bj * 128 + wc * 32 + 8 * fq; const size_t off = (size_t)row * 512 + col;
                f32x4 a = acc[ai][bj][m][0] + *(const f32x4*)(bias + col), b = acc[ai][bj][m][1] + *(const f32x4*)(bias + col + 4);
                f32x4 za, zb; unpack8(*(const u32x4*)(z + off), za, zb);
#pragma unroll
                for (int e = 0; e < 4; ++e) { a[e] = za[e] * sigmoidf_(a[e]); b[e] = zb[e] * sigmoidf_(b[e]); }
                *(u32x4*)(oc + (size_t)row * ldo + col) = pack8(a, b); }
        EPI_ROWS_END
    }
};
template <int IDX> struct EpiMerge {
    static constexpr bool PERM = true, HOOK = false, PRE = false;
    const bf16_t* gates; float* mf; bf16_t* out;
    __device__ __forceinline__ void operator()(const f32x4 (&acc)[2][2][4][2], const Unit& u, int wr, int wc, int fr, int fq) const {
        EPI_ROWS_BEGIN
#pragma unroll
            for (int bj = 0; bj < 2; ++bj) { const int col = u.pn * 256 + bj * 128 + wc * 32 + 8 * fq; const size_t off = (size_t)row * 1024 + col;
                f32x4 ga, gb; unpack8(*(const u32x4*)(gates + (size_t)row * 3072 + IDX * 1024 + col), ga, gb);
                f32x4 a = acc[ai][bj][m][0] * ga, b = acc[ai][bj][m][1] * gb;
                if (IDX > 0) { a += *(const f32x4*)(mf + off); b += *(const f32x4*)(mf + off + 4); }
                if (IDX < 2) { *(f32x4*)(mf + off) = a; *(f32x4*)(mf + off + 4) = b; }
                else *(u32x4*)(out + off) = pack8(a, b); }
        EPI_ROWS_END
    }
};
struct EpiMergeF {
    static constexpr bool PERM = true, HOOK = true, PRE = false;
    const bf16_t* gates; bf16_t* out;
    __device__ __forceinline__ void hook(f32x4 (&acc)[2][2][4][2], const Unit& u, int t, int wr, int wc, int fr, int fq) const {
        const int nx = t >> 3;
        EPI_ROWS_BEGIN
#pragma unroll
            for (int bj = 0; bj < 2; ++bj) { const int col = u.pn * 256 + bj * 128 + wc * 32 + 8 * fq; const bf16_t* gp = gates + (size_t)row * 3072 + (nx - 1) * 1024 + col;
                f32x4 pa, pb, na, nb; unpack8(*(const u32x4*)gp, pa, pb); unpack8(*(const u32x4*)(gp + 1024), na, nb);
#pragma unroll
                for (int e = 0; e < 4; ++e) { acc[ai][bj][m][0][e] *= pa[e] * __builtin_amdgcn_rcpf(na[e]); acc[ai][bj][m][1][e] *= pb[e] * __builtin_amdgcn_rcpf(nb[e]); } }
        EPI_ROWS_END
    }
    __device__ __forceinline__ void operator()(const f32x4 (&acc)[2][2][4][2], const Unit& u, int wr, int wc, int fr, int fq) const {
        EPI_ROWS_BEGIN
#pragma unroll
            for (int bj = 0; bj < 2; ++bj) { const int col = u.pn * 256 + bj * 128 + wc * 32 + 8 * fq;
                f32x4 ga, gb; unpack8(*(const u32x4*)(gates + (size_t)row * 3072 + 2048 + col), ga, gb);
                *(u32x4*)(out + (size_t)row * 1024 + col) = pack8(acc[ai][bj][m][0] * ga, acc[ai][bj][m][1] * gb); }
        EPI_ROWS_END
    }
};
struct EpiResid {
    static constexpr bool PERM = true, HOOK = false, PRE = false;
    const float* xi; float* xo;
    __device__ __forceinline__ void operator()(const f32x4 (&acc)[2][2][4][2], const Unit& u, int wr, int wc, int fr, int fq) const {
        EPI_ROWS_BEGIN
#pragma unroll
            for (int bj = 0; bj < 2; ++bj) { const size_t off = (size_t)row * 1024 + u.pn * 256 + bj * 128 + wc * 32 + 8 * fq;
                *(f32x4*)(xo + off) = *(const f32x4*)(xi + off) + acc[ai][bj][m][0]; *(f32x4*)(xo + off + 4) = *(const f32x4*)(xi + off + 4) + acc[ai][bj][m][1]; }
        EPI_ROWS_END
    }
};
struct EpiResidN {
    static constexpr bool PERM = true, HOOK = false, PRE = false;
    const float* xi; float* xo; const float* gnext; bf16_t* hn; float* ssq; PG8_LAS float* xch;
    __device__ __forceinline__ void operator()(const f32x4 (&acc)[2][2][4][2], const Unit& u, int wr, int wc, int fr, int fq) const {
        f32x4 gv[2][2];
#pragma unroll
        for (int bj = 0; bj < 2; ++bj) { const float* gp = gnext + u.pn * 256 + bj * 128 + wc * 32 + 8 * fq; gv[bj][0] = *(const f32x4*)gp; gv[bj][1] = *(const f32x4*)(gp + 4); }
        EPI_ROWS_BEGIN
            float ss = 0.f;
#pragma unroll
            for (int bj = 0; bj < 2; ++bj) { const size_t off = (size_t)row * 1024 + u.pn * 256 + bj * 128 + wc * 32 + 8 * fq;
                const f32x4 a = *(const f32x4*)(xi + off) + acc[ai][bj][m][0], b = *(const f32x4*)(xi + off + 4) + acc[ai][bj][m][1];
                *(f32x4*)(xo + off) = a; *(f32x4*)(xo + off + 4) = b;
#pragma unroll
                for (int e = 0; e < 4; ++e) ss += a[e] * a[e] + b[e] * b[e];
                *(u32x4*)(hn + off) = pack8(a * gv[bj][0], b * gv[bj][1]); }
            ss += shx(ss, 16, fq * 16 + fr); ss += shx(ss, 32, fq * 16 + fr);
            if (fq == 0) xch[rt * 4 + wc] = ss;
        EPI_ROWS_END
        asm volatile("s_waitcnt lgkmcnt(0)" ::: "memory"); __builtin_amdgcn_s_barrier(); asm volatile("" ::: "memory");
        if (wc == 0 && fq == 0) {
            EPI_ROWS_BEGIN
                const f32x4 q = *(const PG8_LAS f32x4*)(xch + rt * 4);
                ssq[(size_t)row * 4 + u.pn] = (q[0] + q[1]) + (q[2] + q[3]);
            EPI_ROWS_END
        }
    }
};
#define DPP_SHR1(o, s) __int_as_float(__builtin_amdgcn_update_dpp(__float_as_int(o), __float_as_int(s), 0x111, 0xf, 0xf, false))
#define DPP_SHR2(o, s) __int_as_float(__builtin_amdgcn_update_dpp(__float_as_int(o), __float_as_int(s), 0x112, 0xf, 0xf, false))
#define DPP_ROR1(s) __int_as_float(__builtin_amdgcn_update_dpp(0, __float_as_int(s), 0x121, 0xf, 0xf, false))
#define DPP_ROR2(s) __int_as_float(__builtin_amdgcn_update_dpp(0, __float_as_int(s), 0x122, 0xf, 0xf, false))
struct EpiUpConv {
    static constexpr bool PERM = true, HOOK = false, PRE = true;
    bf16_t* act; const float* ssq; const float* cw; const float* cb; PG8_LAS float* xch;
    __device__ __forceinline__ void prefetch(f32x4 (&q)[8], const Unit& u, int wr, int fr) const {
#pragma unroll
        for (int i = 0; i < 8; ++i) { int gr = 254 * u.pm - 2 + (i >> 2) * 128 + wr * 64 + (i & 3) * 16 + fr; gr = gr < 0 ? 0 : (gr > 16383 ? 16383 : gr); q[i] = *(const f32x4*)(ssq + (size_t)gr * 4); }
    }
    __device__ __forceinline__ void run(const f32x4 (&acc)[2][2][4][2], const f32x4 (&q)[8], const Unit& u, int wr, int wc, int fr, int fq) const {
        const int row0 = 254 * u.pm - 2, colw = wc * 32 + 8 * fq, col = u.pn * 128 + colw;
        float rsr[8];
#pragma unroll
        for (int i = 0; i < 8; ++i) rsr[i] = __builtin_amdgcn_rsqf(((q[i][0] + q[i][1]) + (q[i][2] + q[i][3])) * (1.0f / 1024.0f) + 1e-6f);
        const f32x4 w0a = *(const f32x4*)(cw + col), w0b = *(const f32x4*)(cw + col + 4), w1a = *(const f32x4*)(cw + 2816 + col), w1b = *(const f32x4*)(cw + 2816 + col + 4);
        const f32x4 w2a = *(const f32x4*)(cw + 5632 + col), w2b = *(const f32x4*)(cw + 5632 + col + 4), ba = *(const f32x4*)(cb + col), bb = *(const f32x4*)(cb + col + 4);
#pragma unroll
        for (int ai = 0; ai < 2; ++ai) if (fr >= 14) { PG8_LAS float* p = xch + (((ai * 2 + wr) * 2 + (fr - 14)) * 128 + colw);
            *(PG8_LAS f32x4*)p = acc[ai][0][3][0] * rsr[ai * 4 + 3]; *(PG8_LAS f32x4*)(p + 4) = acc[ai][0][3][1] * rsr[ai * 4 + 3]; }
        asm volatile("s_waitcnt lgkmcnt(0)" ::: "memory"); __builtin_amdgcn_s_barrier(); asm volatile("" ::: "memory");
#pragma unroll
        for (int ai = 0; ai < 2; ++ai) {
            f32x4 pv0 = (f32x4){0.f, 0.f, 0.f, 0.f}, pv1 = pv0;
#pragma unroll
            for (int m = 0; m < 4; ++m) {
                const float rs_ = rsr[ai * 4 + m];
                const f32x4 c0 = acc[ai][0][m][0] * rs_, c1 = acc[ai][0][m][1] * rs_;
                f32x4 t1a, t1b, t2a, t2b;
                if (m == 0) {
                    const int s = ai * 2 + wr; t1a = (f32x4){0.f, 0.f, 0.f, 0.f}; t1b = t1a; t2a = t1a; t2b = t1a;
                    if (s > 0 && fr < 2) { const PG8_LAS float* pp = xch + ((s - 1) * 2) * 128 + colw;
                        const f32x4 r62a = *(const PG8_LAS f32x4*)pp, r62b = *(const PG8_LAS f32x4*)(pp + 4), r63a = *(const PG8_LAS f32x4*)(pp + 128), r63b = *(const PG8_LAS f32x4*)(pp + 132);
                        if (fr == 0) { t1a = r63a; t1b = r63b; t2a = r62a; t2b = r62b; } else { t2a = r63a; t2b = r63b; } }
                } else {
#pragma unroll
                    for (int e = 0; e < 4; ++e) { t1a[e] = DPP_ROR1(pv0[e]); t1b[e] = DPP_ROR1(pv1[e]); t2a[e] = DPP_ROR2(pv0[e]); t2b[e] = DPP_ROR2(pv1[e]); }
                }
                f32x4 p1a, p1b, p2a, p2b;
#pragma unroll
                for (int e = 0; e < 4; ++e) { p1a[e] = DPP_SHR1(t1a[e], c0[e]); p1b[e] = DPP_SHR1(t1b[e], c1[e]); p2a[e] = DPP_SHR2(t2a[e], c0[e]); p2b[e] = DPP_SHR2(t2b[e], c1[e]); }
                const int rt = ai * 128 + wr * 64 + m * 16 + fr, gr = row0 + rt, tt = gr & 8191;
                const f32x4 zero4 = (f32x4){0.f, 0.f, 0.f, 0.f};
                if (tt == 0) { p1a = zero4; p1b = zero4; } if (tt <= 1) { p2a = zero4; p2b = zero4; }
                f32x4 va = ba + w0a * p2a + w1a * p1a + w2a * c0, vb = bb + w0b * p2b + w1b * p1b + w2b * c1;
                const f32x4 ga = acc[ai][1][m][0] * rs_, gb = acc[ai][1][m][1] * rs_;
#pragma unroll
                for (int e = 0; e < 4; ++e) { va[e] = va[e] * sigmoidf_(va[e]) * ga[e]; vb[e] = vb[e] * sigmoidf_(vb[e]) * gb[e]; }
                if (rt >= 2 && gr < 16384) *(u32x4*)(act + (size_t)gr * 2816 + col) = pack8(va, vb);
                pv0 = c0; pv1 = c1;
                asm volatile("" ::: "memory");
            }
        }
    }
};
struct EpiUp {
    static constexpr bool PERM = true, HOOK = false, PRE = false;
    bf16_t* fa; bf16_t* fb; const float* ssq;
    __device__ __forceinline__ void operator()(const f32x4 (&acc)[2][2][4][2], const Unit& u, int wr, int wc, int fr, int fq) const {
        float rsr[8]; row_rstd(rsr, ssq, u, wr, fr);
        EPI_ROWS_BEGIN
            const size_t off = (size_t)row * 2816 + u.pn * 128 + wc * 32 + 8 * fq; const float rs_ = rsr[ai * 4 + m];
            *(u32x4*)(fa + off) = pack8(acc[ai][0][m][0] * rs_, acc[ai][0][m][1] * rs_);
            *(u32x4*)(fb + off) = pack8(acc[ai][1][m][0] * rs_, acc[ai][1][m][1] * rs_);
        EPI_ROWS_END
    }
};
template <class Epi, class Sched, bool ALIGN_EPI = false, bool SP2 = false>
__device__ __forceinline__ void gemm_phase(PG8_LAS unsigned char* lds, const Gemm g, const Sched& S, const Epi& E) {
    int tid_ = threadIdx.x; asm volatile("" : "+v"(tid_));
    const int tid = tid_, wid = __builtin_amdgcn_readfirstlane(tid >> 6), lane = tid & 63, wr = wid >> 2, wc = wid & 3, fr = lane & 15, fq = lane >> 4;
    const int K = g.K, nt = K / BK;
    unsigned voffA[2], voffB[2];
#pragma unroll
    for (int i = 0; i < 2; ++i) { int R, C; stage_rc(tid * 16 + i * 8192, R, C); const int Rb = Epi::PERM ? ((R & ~31) + perm32(R & 31)) : R;
        voffA[i] = (unsigned)(R * g.a_row + (C >> 4) * g.a_c16 + (C & 15) * 2); voffB[i] = (unsigned)(Rb * K + C) * 2u; }
    const size_t kstep = (size_t)(BK * 2), kstepA = (size_t)g.a_kt;
    const size_t hstep = (size_t)HALF * K * 2, hstepA = (size_t)HALF * g.a_row;
    const unsigned ldsw = (unsigned)wid * 1024u;
    const int aoff = lds_byte(wr * 64 + fr, fq * 8), boff = lds_byte(wc * 32 + fr, fq * 8);
#define PG8_SA(b, h) (((b) * 2 + (h)) * HTB)
#define PG8_SB(b, h) ((4 + (b) * 2 + (h)) * HTB)
#define PG8_STAGE(bufoff, gbase, voff) do { _Pragma("unroll") for (int _i = 0; _i < 2; ++_i) \
        __builtin_amdgcn_global_load_lds((const unsigned*)((const char*)(gbase) + (voff)[_i]), (PG8_LAS unsigned*)(lds + (bufoff) + ldsw + _i * 8192), 16, 0, 0); } while (0)
#define PG8_LDA(dst, b, h) do { _Pragma("unroll") for (int m = 0; m < 4; ++m) _Pragma("unroll") for (int k = 0; k < 2; ++k) dst[m][k] = *(const PG8_LAS bf16x8*)(lds + PG8_SA(b, h) + aoff + m * 2048 + k * 1024); } while (0)
#define PG8_LDB(dst, b, h) do { _Pragma("unroll") for (int n = 0; n < 2; ++n) _Pragma("unroll") for (int k = 0; k < 2; ++k) dst[n][k] = *(const PG8_LAS bf16x8*)(lds + PG8_SB(b, h) + boff + n * 2048 + k * 1024); } while (0)
#define PG8_MMA(ai, bj, At, Bt) do { __builtin_amdgcn_s_setprio(1); _Pragma("unroll") for (int m = 0; m < 4; ++m) _Pragma("unroll") for (int n = 0; n < 2; ++n) _Pragma("unroll") for (int k = 0; k < 2; ++k) \
        acc[ai][bj][m][n] = __builtin_amdgcn_mfma_f32_16x16x32_bf16(Bt[n][k], At[m][k], acc[ai][bj][m][n], 0, 0, 0); __builtin_amdgcn_s_setprio(0); } while (0)
#define PG8_WAIT_V(n) asm volatile("s_waitcnt vmcnt(" #n ")" ::: "memory")
#define PG8_WAIT_L(n) asm volatile("s_waitcnt lgkmcnt(" #n ")" ::: "memory")
#define PG8_BAR __builtin_amdgcn_s_barrier()
#define PG8_SCHED __builtin_amdgcn_sched_barrier(0)
    Unit cur, nxt; int ui = 0;
    if (!S.next(0, cur)) return;
    f32x4 acc[2][2][4][2];
#pragma unroll
    for (int a = 0; a < 2; ++a)
#pragma unroll
        for (int b = 0; b < 2; ++b)
#pragma unroll
            for (int m = 0; m < 4; ++m)
#pragma unroll
                for (int n = 0; n < 2; ++n) acc[a][b][m][n] = (f32x4){0.f, 0.f, 0.f, 0.f};
    bf16x8 At[4][2], B0[2][2], B1[2][2];
    const char* cA = (const char*)g.A + S.offA(cur); const char* cB = (const char*)g.Bt + S.offB(cur);
    if constexpr (SP2) {
        PG8_STAGE(PG8_SB(0, 0), cB, voffB); PG8_STAGE(PG8_SB(0, 1), cB + hstep, voffB); PG8_STAGE(PG8_SA(0, 0), cA, voffA); PG8_STAGE(PG8_SA(0, 1), cA + hstepA, voffA);
        if (wr == 1) PG8_BAR;
        PG8_WAIT_V(2); PG8_BAR;
        PG8_STAGE(PG8_SB(1, 0), cB + kstep, voffB); PG8_STAGE(PG8_SA(1, 0), cA + kstepA, voffA); PG8_STAGE(PG8_SB(1, 1), cB + hstep + kstep, voffB);
        PG8_WAIT_V(6); PG8_BAR;
    } else {
        PG8_STAGE(PG8_SB(0, 0), cB, voffB); PG8_STAGE(PG8_SA(0, 0), cA, voffA); PG8_STAGE(PG8_SB(0, 1), cB + hstep, voffB); PG8_STAGE(PG8_SA(0, 1), cA + hstepA, voffA);
        if (wr == 1) PG8_BAR;
        PG8_WAIT_V(4); PG8_BAR;
        PG8_STAGE(PG8_SB(1, 0), cB + kstep, voffB); PG8_STAGE(PG8_SA(1, 0), cA + kstepA, voffA); PG8_STAGE(PG8_SB(1, 1), cB + hstep + kstep, voffB);
        PG8_WAIT_V(6); PG8_BAR;
    }
    for (;;) {
        const bool has_next = S.next(ui + 1, nxt);
        const char* nA = has_next ? (const char*)g.A + S.offA(nxt) : cA; const char* nB = has_next ? (const char*)g.Bt + S.offB(nxt) : cB;
        for (int t = 0; t < nt; t += 2) {
            if constexpr (Epi::HOOK) { if (t == 8 || t == 16) { int fr_ = fr, fq_ = fq; asm volatile("" : "+v"(fr_), "+v"(fq_)); E.hook(acc, cur, t, wr, wc, fr_, fq_); } }
            const bool last = (t == nt - 2);
            const char* a1 = cA + (size_t)(t + 1) * kstepA;
            const char* a2 = last ? nA : cA + (size_t)(t + 2) * kstepA; const char* b2 = last ? nB : cB + (size_t)(t + 2) * kstep;
            const char* a3 = a2 + kstepA; const char* b3 = b2 + kstep;
            if constexpr (SP2) {
            PG8_LDB(B0, 0, 0); PG8_LDB(B1, 0, 1); PG8_SCHED; PG8_LDA(At, 0, 0); PG8_STAGE(PG8_SA(1, 1), a1 + hstepA, voffA);
            PG8_WAIT_V(8); PG8_WAIT_L(0); PG8_BAR; PG8_MMA(0, 0, At, B0); PG8_MMA(0, 1, At, B1); PG8_BAR; PG8_SCHED;
            PG8_LDA(At, 0, 1); PG8_STAGE(PG8_SB(0, 0), b2, voffB); PG8_STAGE(PG8_SB(0, 1), b2 + hstep, voffB); PG8_STAGE(PG8_SA(0, 0), a2, voffA);
            PG8_WAIT_V(8); PG8_WAIT_L(0); PG8_BAR; PG8_MMA(1, 0, At, B0); PG8_MMA(1, 1, At, B1); PG8_BAR; PG8_SCHED;
            PG8_LDB(B0, 1, 0); PG8_LDB(B1, 1, 1); PG8_SCHED; PG8_LDA(At, 1, 0); PG8_STAGE(PG8_SA(0, 1), a2 + hstepA, voffA);
            PG8_WAIT_V(8); PG8_WAIT_L(0); PG8_BAR; PG8_MMA(0, 0, At, B0); PG8_MMA(0, 1, At, B1); PG8_BAR; PG8_SCHED;
            PG8_LDA(At, 1, 1); PG8_STAGE(PG8_SB(1, 0), b3, voffB); PG8_STAGE(PG8_SB(1, 1), b3 + hstep, voffB); PG8_STAGE(PG8_SA(1, 0), a3, voffA);
            PG8_WAIT_V(8); PG8_WAIT_L(0); PG8_BAR; PG8_MMA(1, 0, At, B0); PG8_MMA(1, 1, At, B1); PG8_BAR; PG8_SCHED;
            } else {
            PG8_LDB(B0, 0, 0); PG8_SCHED; PG8_LDA(At, 0, 0); PG8_STAGE(PG8_SA(1, 1), a1 + hstepA, voffA);
            PG8_WAIT_L(8); PG8_BAR; PG8_WAIT_L(0); PG8_MMA(0, 0, At, B0); PG8_BAR; PG8_SCHED;
            PG8_LDB(B1, 0, 1); PG8_STAGE(PG8_SB(0, 0), b2, voffB);
            PG8_BAR; PG8_WAIT_L(0); PG8_MMA(0, 1, At, B1); PG8_BAR;
            PG8_LDA(At, 0, 1); PG8_STAGE(PG8_SA(0, 0), a2, voffA);
            PG8_BAR; PG8_WAIT_L(0); PG8_MMA(1, 0, At, B0); PG8_BAR; PG8_SCHED;
            PG8_STAGE(PG8_SB(0, 1), b2 + hstep, voffB);
            PG8_WAIT_V(6); PG8_BAR; PG8_MMA(1, 1, At, B1); PG8_BAR;
            PG8_LDB(B0, 1, 0); PG8_SCHED; PG8_LDA(At, 1, 0); PG8_STAGE(PG8_SA(0, 1), a2 + hstepA, voffA);
            PG8_WAIT_L(8); PG8_BAR; PG8_WAIT_L(0); PG8_MMA(0, 0, At, B0); PG8_BAR; PG8_SCHED;
            PG8_LDB(B1, 1, 1); PG8_STAGE(PG8_SB(1, 0), b3, voffB);
            PG8_BAR; PG8_WAIT_L(0); PG8_MMA(0, 1, At, B1); PG8_BAR;
            PG8_LDA(At, 1, 1); PG8_STAGE(PG8_SA(1, 0), a3, voffA);
            PG8_BAR; PG8_WAIT_L(0); PG8_MMA(1, 0, At, B0); PG8_BAR; PG8_SCHED;
            PG8_STAGE(PG8_SB(1, 1), b3 + hstep, voffB);
            PG8_WAIT_V(6); PG8_BAR; PG8_MMA(1, 1, At, B1); PG8_BAR;
            }
        }
        f32x4 preq[8]; if constexpr (Epi::PRE) { int fr_ = fr; asm volatile("" : "+v"(fr_)); E.prefetch(preq, cur, wr, fr_); }
        if constexpr (ALIGN_EPI) { if (wr == 0) PG8_BAR; }
        { int fr_ = fr, fq_ = fq; asm volatile("" : "+v"(fr_), "+v"(fq_)); if constexpr (Epi::PRE) E.run(acc, preq, cur, wr, wc, fr_, fq_); else E(acc, cur, wr, wc, fr_, fq_); }
        if (!has_next) break;
#pragma unroll
        for (int a = 0; a < 2; ++a)
#pragma unroll
            for (int b = 0; b < 2; ++b)
#pragma unroll
                for (int m = 0; m < 4; ++m)
#pragma unroll
                    for (int n = 0; n < 2; ++n) acc[a][b][m][n] = (f32x4){0.f, 0.f, 0.f, 0.f};
        cur = nxt; cA = nA; cB = nB; ++ui;
        if constexpr (ALIGN_EPI) { if (wr == 1) PG8_BAR; }
    }
    PG8_WAIT_V(0);
    if constexpr (!ALIGN_EPI) { if (wr == 0) PG8_BAR; }
    PG8_BAR;
#undef PG8_SA
#undef PG8_SB
#undef PG8_STAGE
#undef PG8_LDA
#undef PG8_LDB
#undef PG8_MMA
#undef PG8_WAIT_V
#undef PG8_WAIT_L
#undef PG8_BAR
#undef PG8_SCHED
}
}

#include <hip/hip_bf16.h>
#include <cmath>
namespace attn_body {
using bf16=__hip_bfloat16;
using bf16x8=__attribute__((ext_vector_type(8)))short;
using s16x4=__attribute__((ext_vector_type(4)))short;
using f32x16=__attribute__((ext_vector_type(16)))float;
using u32x4=__attribute__((ext_vector_type(4)))unsigned;
constexpr int BATCH=2,NHEAD=16,SEQ=8192,D=64,DM=NHEAD*D, QP=64,KP=64,VP=128,OP=1024;
constexpr int NW=8,QBLK=32,QB=QBLK*NW,KVBLK=64,NQB=SEQ/QB;
constexpr int ATTN_PITCH=DM, ATTN_UNIT_ROWS=QB;
__device__ __forceinline__ int crow(int r,int hi){return (r&3)+8*(r>>2)+4*hi;}
#define SBAR() __builtin_amdgcn_sched_barrier(0)
__device__ __forceinline__ void cmask(f32x16&p0,f32x16&p1,int jb,int qrel,int hi){
  const float NEG=-INFINITY; int kb=64*jb+4*hi;
  #pragma unroll
  for(int r=0;r<16;++r){int kv=kb+(r&3)+8*(r>>2); if(kv>qrel)p0[r]=NEG; if(kv+32>qrel)p1[r]=NEG;}
}

constexpr int NSLOT=3, SLOTB=8192;
constexpr int LDS_K=0, LDS_V=NSLOT*SLOTB, LDS_WS=2*NSLOT*SLOTB, LDS_OST=LDS_WS+NW*64*4, LDS_BYTES=LDS_OST+NW*4096;
constexpr float C2=0.125f*1.4426950408889634f;
__device__ __forceinline__ void glds16(const void*gsrc,unsigned lds_dst){unsigned keep;
  asm volatile("s_mov_b32 %0, m0\n\ts_mov_b32 m0, %2\n\ts_nop 0\n\tglobal_load_lds_dwordx4 %1, off\n\ts_mov_b32 m0, %0":"=&s"(keep):"v"(gsrc),"s"(lds_dst):"memory");}
__device__ __forceinline__ float max3f(float a,float b,float c){float r;asm("v_max3_f32 %0, %1, %2, %3":"=v"(r):"v"(a),"v"(b),"v"(c));return r;}
__device__ __forceinline__ float max2f(float a,float b){float r;asm("v_max_f32_e32 %0, %1, %2":"=v"(r):"v"(a),"v"(b));return r;}
__device__ __forceinline__ float fadd_s(float a,float b){float r;asm("v_add_f32_e32 %0, %1, %2":"=v"(r):"v"(a),"v"(b));return r;}
__device__ __forceinline__ float fsub_s(float a,float b){float r;asm("v_sub_f32_e32 %0, %1, %2":"=v"(r):"v"(a),"v"(b));return r;}
typedef float f32x2_t __attribute__((ext_vector_type(2))); typedef __bf16 bf16x2_t __attribute__((ext_vector_type(2)));
__device__ __forceinline__ unsigned cvtpk_s(float lo,float hi){f32x2_t v={lo,hi};bf16x2_t b=__builtin_convertvector(v,bf16x2_t);return __builtin_bit_cast(unsigned,b);}
#define WAIT_BAR(N) asm volatile("s_waitcnt vmcnt(" #N ") lgkmcnt(0)\n\ts_barrier":::"memory")

__device__ __forceinline__ void qkt(f32x16&p0,f32x16&p1,const char*Kslot,const bf16x8*qr,const f32x16&negm,int r32,int hi){
  const char*kb=Kslot+hi*1024+r32*16;
  #pragma unroll
  for(int d0=0;d0<4;++d0){
    const bf16x8 b0=*reinterpret_cast<const bf16x8*>(kb+d0*2048);
    const bf16x8 b1=*reinterpret_cast<const bf16x8*>(kb+d0*2048+512);
    if(d0==0){p0=__builtin_amdgcn_mfma_f32_32x32x16_bf16(b0,qr[0],negm,0,0,0);p1=__builtin_amdgcn_mfma_f32_32x32x16_bf16(b1,qr[0],negm,0,0,0);}
    else{p0=__builtin_amdgcn_mfma_f32_32x32x16_bf16(b0,qr[d0],p0,0,0,0);p1=__builtin_amdgcn_mfma_f32_32x32x16_bf16(b1,qr[d0],p1,0,0,0);}}
}
typedef __attribute__((address_space(3))) const char* lds_cptr;
typedef short v4i16_t __attribute__((ext_vector_type(4)));
__device__ __forceinline__ void kload8(bf16x8*kf,lds_cptr kp){
  kf[0]=*(const __attribute__((address_space(3))) bf16x8*)(kp);      kf[1]=*(const __attribute__((address_space(3))) bf16x8*)(kp+512);
  kf[2]=*(const __attribute__((address_space(3))) bf16x8*)(kp+2048); kf[3]=*(const __attribute__((address_space(3))) bf16x8*)(kp+2560);
  kf[4]=*(const __attribute__((address_space(3))) bf16x8*)(kp+4096); kf[5]=*(const __attribute__((address_space(3))) bf16x8*)(kp+4608);
  kf[6]=*(const __attribute__((address_space(3))) bf16x8*)(kp+6144); kf[7]=*(const __attribute__((address_space(3))) bf16x8*)(kp+6656);
}
__device__ __forceinline__ void kload2(bf16x8*kf,lds_cptr kp,int j){ kf[2*j]=*(const __attribute__((address_space(3))) bf16x8*)(kp+j*2048); kf[2*j+1]=*(const __attribute__((address_space(3))) bf16x8*)(kp+j*2048+512); }
__device__ __forceinline__ s16x4 vtr(lds_cptr p){ return __builtin_bit_cast(s16x4,__builtin_amdgcn_ds_read_tr16_b64_v4i16((__attribute__((address_space(3))) v4i16_t*)p)); }
__device__ __forceinline__ float rowmax(const f32x16&p0,const f32x16&p1){
  float a=max3f(p0[0],p0[1],p1[0]),b=max3f(p0[2],p0[3],p1[1]);a=max3f(a,p1[2],p1[3]);
  #pragma unroll
  for(int r=4;r<16;r+=4){a=max3f(a,p0[r],p0[r+1]);b=max3f(b,p0[r+2],p0[r+3]);a=max3f(a,p1[r],p1[r+1]);b=max3f(b,p1[r+2],p1[r+3]);}
  const float m=max2f(a,b);
  auto rr=__builtin_amdgcn_permlane32_swap(__float_as_uint(m),__float_as_uint(m),false,false);
  return max2f(__uint_as_float(rr[0]),__uint_as_float(rr[1]));
}
__device__ __forceinline__ void pv(f32x16*o,int vb,bf16x8 pa0,bf16x8 pa1,bf16x8 pa2,bf16x8 pa3){
  #pragma unroll
  for(int d0=0;d0<2;++d0){s16x4 lo[4],hi[4];
    #pragma unroll
    for(int ks=0;ks<4;++ks){
      asm volatile("ds_read_b64_tr_b16 %0,%1 offset:%c2":"=&v"(lo[ks]):"v"(vb),"i"(d0*4096+ks*1024):"memory");
      asm volatile("ds_read_b64_tr_b16 %0,%1 offset:%c2":"=&v"(hi[ks]):"v"(vb),"i"(d0*4096+ks*1024+512):"memory");}
    asm volatile("s_waitcnt lgkmcnt(0)":::"memory");SBAR();
    #define PK(k) (bf16x8){lo[k][0],lo[k][1],lo[k][2],lo[k][3],hi[k][0],hi[k][1],hi[k][2],hi[k][3]}
    o[d0]=__builtin_amdgcn_mfma_f32_32x32x16_bf16(pa0,PK(0),o[d0],0,0,0);
    o[d0]=__builtin_amdgcn_mfma_f32_32x32x16_bf16(pa1,PK(1),o[d0],0,0,0);
    o[d0]=__builtin_amdgcn_mfma_f32_32x32x16_bf16(pa2,PK(2),o[d0],0,0,0);
    o[d0]=__builtin_amdgcn_mfma_f32_32x32x16_bf16(pa3,PK(3),o[d0],0,0,0);
    #undef PK
  }
}

#ifndef ATTN_STORE16
#define ATTN_STORE16(p,v) (*(u32x4*)(p)=(v))
#endif
template<int THRL> __device__ __forceinline__ void attn_unit(int b,int h,int qb,const bf16*Q,const bf16*__restrict__ K,const bf16*__restrict__ V,bf16*O,char*shm){
  int tid_=threadIdx.x; asm volatile("":"+v"(tid_)); const int tid=tid_,lane=tid&63,r32=lane&31,hi=lane>>5; const int wid=__builtin_amdgcn_readfirstlane(tid>>6);
  const long rowbase=(long)b*SEQ; const int q0=qb*QB;
  const bf16*Qw=Q+((long)(h>>1)*(BATCH*SEQ)+rowbase+q0+wid*QBLK)*QP;
  const bf16*Kh=K+((long)(h>>1)*(BATCH*SEQ)+rowbase)*KP,*Vh=V+((long)(h>>2)*(BATCH*SEQ)+rowbase)*VP+(h&1)*64;
  const unsigned lds0=(unsigned)(uintptr_t)shm;
  float*wsf=(float*)(shm+LDS_WS)+wid*64;
  const bf16*ksrc=Kh+(long)lane*KP+wid*8;
  const bf16*vsrc=Vh+(long)(16*(wid&3)+(lane>>2))*VP+(wid>>2)*32+(lane&3)*8;
  const unsigned kdst=lds0+LDS_K+wid*1024, vdst=lds0+LDS_V+wid*1024;
  #define DMA_K(t,slot) glds16(ksrc+(long)(t)*KVBLK*KP,(unsigned)__builtin_amdgcn_readfirstlane(kdst+(slot)))
  #define DMA_V(t,slot) glds16(vsrc+(long)(t)*KVBLK*VP,(unsigned)__builtin_amdgcn_readfirstlane(vdst+(slot)))
  const int vb0=(int)(lds0+LDS_V)+((lane>>4)&1)*32+(lane&3)*8+(4*hi+((lane&15)>>2))*64;
  const char*Kbase=shm+LDS_K; bf16x8 kf[8];
  const lds_cptr shm3=(lds_cptr)shm; const lds_cptr kp0=shm3+LDS_K+hi*1024+r32*16; const lds_cptr vp0=shm3+LDS_V+((lane>>4)&1)*32+(lane&3)*8+(4*hi+((lane&15)>>2))*64;
  const int NT=(q0+QB)/KVBLK;
  DMA_K(0,0);DMA_V(0,0);DMA_K(1,SLOTB);
  bf16x8 qr[4];
  #pragma unroll
  for(int d0=0;d0<4;++d0)qr[d0]=*reinterpret_cast<const bf16x8*>(&Qw[(long)r32*QP+d0*16+hi*8]);
  float mhat=0.f,l_reg=0.f;f32x16 o[2];o[0]=f32x16{};o[1]=f32x16{};f32x16 negm=f32x16{};asm volatile("":"+v"(negm));
  const int qrel=wid*QBLK+r32;
  #define CMASK(P0,P1,t) do{int jb_=(t)-(NT-4); if(jb_>=0)cmask(P0,P1,jb_,qrel,hi);}while(0)
  bool resc=false;
  #define START(P0,P1) do{ const float rm=rowmax(P0,P1); resc=false; \
    { const float dl=rm; mhat=fadd_s(mhat,dl); \
      _Pragma("unroll") for(int r=0;r<16;++r){P0[r]=fsub_s(P0[r],dl);P1[r]=fsub_s(P1[r],dl);} \
      _Pragma("unroll") for(int r=0;r<16;++r)negm[r]=-mhat; asm volatile("":"+v"(negm)); } \
    _Pragma("unroll") for(int r=0;r<16;++r)P0[r]=__builtin_amdgcn_exp2f(P0[r]); }while(0)
  #define RESC() do{ if(resc){ asm volatile("s_waitcnt lgkmcnt(0)":::"memory"); \
      _Pragma("unroll") for(int d_=0;d_<2;++d_) _Pragma("unroll") for(int r=0;r<16;++r)o[d_][r]*=wsf[crow(r,hi)]; } }while(0)
  f32x16 pA0,pA1,pB0,pB1;
  int sl_prev=0,sl_cur=0,sl_next=SLOTB;
  #define ROT() do{sl_prev=sl_cur;sl_cur=sl_next;sl_next=(sl_next==(NSLOT-1)*SLOTB)?0:sl_next+SLOTB;}while(0)
  DMA_K(2,2*SLOTB);
  WAIT_BAR(3);
  qkt(pA0,pA1,Kbase,qr,negm,r32,hi);asm volatile("s_nop 15\n\ts_nop 7":"+v"(pA0),"+v"(pA1));CMASK(pA0,pA1,0);
  START(pA0,pA1);
  _Pragma("unroll") for(int r=0;r<16;++r)pA1[r]=__builtin_amdgcn_exp2f(pA1[r]);
  WAIT_BAR(0);
  DMA_K(3,0);DMA_V(1,SLOTB);
  ROT();
  kload8(kf,kp0+sl_cur);
  WAIT_BAR(2);
  s16x4 vlo[8],vhi[8]; u32x4 pw0,pw1,pw2,pw3;
  #define PKW(P,B) cvtpk_s(P[B],P[B+1])
  #define PAF(k) __builtin_bit_cast(bf16x8,pw##k)
  #define VFR(i) (bf16x8){vlo[i][0],vlo[i][1],vlo[i][2],vlo[i][3],vhi[i][0],vhi[i][1],vhi[i][2],vhi[i][3]}
  #define PIN(x) asm volatile("":"+v"(x))
  #define MX3(a,b,c) __builtin_fmaxf(__builtin_fmaxf((a),(b)),(c))
  #define GAPA(MF,A0,A1,A2,A3,W0,W1,PW) do{ MF; sacc+=A0; sacc+=A1; sacc+=A2; sacc+=A3; PIN(sacc); W0; W1; PIN(PW); SBAR(); }while(0)
  #define EX(v) __builtin_amdgcn_exp2f(v)
  #define GAPB(MF,X,B) do{ MF; X[B]=EX(X[B]); X[B+1]=EX(X[B+1]); X[B+2]=EX(X[B+2]); X[B+3]=EX(X[B+3]); PIN(X); SBAR(); }while(0)
  #define VRD(i) do{ vlo[i]=vtr(vp_+(((i)>>2)*4096+((i)&3)*1024)); vhi[i]=vtr(vp_+(((i)>>2)*4096+((i)&3)*1024+512)); }while(0)
  #define KRD(G,j) do{ if(G){ kload2(kf,kp0+sl_next,j); SBAR(); } }while(0)
  #define STEP(C0,C1,P0,P1,t,GK,GV,GL) do{ SBAR(); \
    const lds_cptr vp_=vp0+sl_prev; \
    VRD(0); SBAR(); float sacc=(P0[0]+P0[1]); \
    GAPA(C0=__builtin_amdgcn_mfma_f32_32x32x16_bf16(kf[0],qr[0],negm,0,0,0), P0[2],P0[3],P0[4],P0[5],     pw0[0]=PKW(P0,0), pw0[1]=PKW(P0,2), pw0); \
    VRD(4); SBAR(); GAPA(C1=__builtin_amdgcn_mfma_f32_32x32x16_bf16(kf[1],qr[0],negm,0,0,0), P0[6],P0[7],P0[8],P0[9],     pw0[2]=PKW(P0,4), pw0[3]=PKW(P0,6), pw0); \
    VRD(1); SBAR(); GAPA(C0=__builtin_amdgcn_mfma_f32_32x32x16_bf16(kf[2],qr[1],C0,0,0,0),   P0[10],P0[11],P0[12],P0[13], pw1[0]=PKW(P0,8), pw1[1]=PKW(P0,10), pw1); \
    VRD(5); SBAR(); GAPA(C1=__builtin_amdgcn_mfma_f32_32x32x16_bf16(kf[3],qr[1],C1,0,0,0),   P0[14],P0[15],P1[0],P1[1],   pw1[2]=PKW(P0,12),pw1[3]=PKW(P0,14), pw1); \
    VRD(2); SBAR(); GAPA(C0=__builtin_amdgcn_mfma_f32_32x32x16_bf16(kf[4],qr[2],C0,0,0,0),   P1[2],P1[3],P1[4],P1[5],     pw2[0]=PKW(P1,0), pw2[1]=PKW(P1,2), pw2); \
    VRD(6); SBAR(); GAPA(C1=__builtin_amdgcn_mfma_f32_32x32x16_bf16(kf[5],qr[2],C1,0,0,0),   P1[6],P1[7],P1[8],P1[9],     pw2[2]=PKW(P1,4), pw2[3]=PKW(P1,6), pw2); \
    VRD(3); SBAR(); GAPA(C0=__builtin_amdgcn_mfma_f32_32x32x16_bf16(kf[6],qr[3],C0,0,0,0),   P1[10],P1[11],P1[12],P1[13], pw3[0]=PKW(P1,8), pw3[1]=PKW(P1,10), pw3); \
    VRD(7); SBAR(); GAPA(C1=__builtin_amdgcn_mfma_f32_32x32x16_bf16(kf[7],qr[3],C1,0,0,0),   P1[14],P1[15],0.f,0.f,       pw3[2]=PKW(P1,12),pw3[3]=PKW(P1,14), pw3); \
    l_reg+=sacc; \
    if(GK){DMA_K((t)+3,sl_cur);} if(GV){DMA_V((t)+1,sl_next);} \
    CMASK(C0,C1,t); \
    { float a=MX3(C0[0],C0[1],C1[0]),b=MX3(C0[2],C0[3],C1[1]); a=MX3(a,C1[2],C1[3]); \
      _Pragma("unroll") for(int r=4;r<16;r+=4){a=MX3(a,C0[r],C0[r+1]);b=MX3(b,C0[r+2],C0[r+3]);a=MX3(a,C1[r],C1[r+1]);b=MX3(b,C1[r+2],C1[r+3]);} \
      float rm=__builtin_fmaxf(a,b); { auto rr=__builtin_amdgcn_permlane32_swap(__float_as_uint(rm),__float_as_uint(rm),false,false); rm=__builtin_fmaxf(__uint_as_float(rr[0]),__uint_as_float(rr[1])); } \
      resc=false; \
      if(__builtin_expect(__any(rm>(float)THRL),0)){ const float dl=__builtin_fmaxf(rm,0.f); mhat+=dl; \
        _Pragma("unroll") for(int r=0;r<16;++r){C0[r]-=dl;C1[r]-=dl;} \
        _Pragma("unroll") for(int r=0;r<16;++r)negm[r]=-mhat; asm volatile("":"+v"(negm)); \
        const float f=__builtin_amdgcn_exp2f(-dl); l_reg*=f; if(hi==0)wsf[r32]=f; resc=true; } } \
    SBAR(); \
    GAPB(o[0]=__builtin_amdgcn_mfma_f32_32x32x16_bf16(PAF(0),VFR(0),o[0],0,0,0), C0,0); \
    GAPB(o[1]=__builtin_amdgcn_mfma_f32_32x32x16_bf16(PAF(0),VFR(4),o[1],0,0,0), C0,4); \
    KRD(GL,0); GAPB(o[0]=__builtin_amdgcn_mfma_f32_32x32x16_bf16(PAF(1),VFR(1),o[0],0,0,0), C0,8); \
    KRD(GL,1); GAPB(o[1]=__builtin_amdgcn_mfma_f32_32x32x16_bf16(PAF(1),VFR(5),o[1],0,0,0), C0,12); \
    KRD(GL,2); GAPB(o[0]=__builtin_amdgcn_mfma_f32_32x32x16_bf16(PAF(2),VFR(2),o[0],0,0,0), C1,0); \
    KRD(GL,3); GAPB(o[1]=__builtin_amdgcn_mfma_f32_32x32x16_bf16(PAF(2),VFR(6),o[1],0,0,0), C1,4); \
    GAPB(o[0]=__builtin_amdgcn_mfma_f32_32x32x16_bf16(PAF(3),VFR(3),o[0],0,0,0), C1,8); \
    GAPB(o[1]=__builtin_amdgcn_mfma_f32_32x32x16_bf16(PAF(3),VFR(7),o[1],0,0,0), C1,12); \
    }while(0)
  int t=1;
  #undef CMASK
  #define CMASK(P0,P1,t) do{}while(0)
  for(;t+5<NT;t+=2){
    STEP(pB0,pB1,pA0,pA1,t,true,true,true);     WAIT_BAR(2); RESC(); ROT();
    STEP(pA0,pA1,pB0,pB1,t+1,true,true,true);   WAIT_BAR(2); RESC(); ROT();
  }
  #undef CMASK
  #define CMASK(P0,P1,t) do{int jb_=(t)-(NT-4); if(jb_>=0)cmask(P0,P1,jb_,qrel,hi);}while(0)
  #define ENDW(tt) do{ if((tt)+3<NT){WAIT_BAR(2);} else if((tt)+2<NT){WAIT_BAR(1);} else {WAIT_BAR(0);} }while(0)
  for(;t+1<NT;t+=2){
    STEP(pB0,pB1,pA0,pA1,t,(t+3<NT),(t+1<NT),(t+1<NT));       ENDW(t);   RESC(); ROT();
    STEP(pA0,pA1,pB0,pB1,t+1,(t+4<NT),(t+2<NT),(t+2<NT));     ENDW(t+1); RESC(); ROT();
  }
  STEP(pB0,pB1,pA0,pA1,NT-1,false,false,false); RESC();
  { float sacc=pB0[0]+pB0[1]; _Pragma("unroll") for(int r=2;r<16;++r)sacc+=pB0[r]; _Pragma("unroll") for(int r=0;r<16;++r)sacc+=pB1[r]; l_reg+=sacc;
    pw0=(u32x4){PKW(pB0,0),PKW(pB0,2),PKW(pB0,4),PKW(pB0,6)};pw1=(u32x4){PKW(pB0,8),PKW(pB0,10),PKW(pB0,12),PKW(pB0,14)};pw2=(u32x4){PKW(pB1,0),PKW(pB1,2),PKW(pB1,4),PKW(pB1,6)};pw3=(u32x4){PKW(pB1,8),PKW(pB1,10),PKW(pB1,12),PKW(pB1,14)};
    SBAR(); pv(o,vb0+sl_cur,PAF(0),PAF(1),PAF(2),PAF(3)); }
  #undef PKW
  #undef PAF
  #undef VFR
  #undef PIN
  #undef MX3
  #undef GAPA
  #undef GAPB
  #undef EX
  #undef VRD
  #undef KRD
  #undef STEP
  #undef ENDW
  {auto rr=__builtin_amdgcn_permlane32_swap(__float_as_uint(l_reg),__float_as_uint(l_reg),false,false);l_reg=__uint_as_float(rr[0])+__uint_as_float(rr[1]);}
  if(hi==0)wsf[32+r32]=l_reg;asm volatile("s_waitcnt lgkmcnt(0)":::"memory");
  float rli[16];
  #pragma unroll
  for(int r=0;r<16;++r)rli[r]=__builtin_amdgcn_rcpf(wsf[32+crow(r,hi)]);
  bf16*Ow=O+(rowbase+q0+wid*QBLK)*OP+h*D;
  { bf16*stg=(bf16*)(shm+LDS_OST)+wid*2048;
    #pragma unroll
    for(int r=0;r<16;++r){const int orow=crow(r,hi);
      #pragma unroll
      for(int d0=0;d0<2;++d0)stg[orow*64+d0*32+r32]=__float2bfloat16(o[d0][r]*rli[r]);}
    asm volatile("s_waitcnt lgkmcnt(0)":::"memory");
    #pragma unroll
    for(int i=0;i<4;++i){const int row=i*8+(lane>>3),ch=lane&7; const u32x4 v=*(const u32x4*)(stg+row*64+ch*8); ATTN_STORE16(Ow+(long)row*OP+ch*8,v);} }
  asm volatile("s_waitcnt lgkmcnt(0)\n\ts_barrier":::"memory");
  #undef DMA_K
  #undef DMA_V
  #undef CMASK
  #undef START
  #undef RESC
  #undef ROT
}
constexpr int ATTN_LDS_BYTES=LDS_BYTES;
struct AttnTensors { const bf16* Q; const bf16* K; const bf16* V; bf16* O; };
struct AttnUnit { int bh; int qb; };
struct StaticOrder {
  int vcu;
  __device__ __forceinline__ explicit StaticOrder(int grid,int block):vcu((block%8)*(grid/8)+block/8){}
  __device__ __forceinline__ bool next(int i,AttnUnit&u)const{ if(i>=4)return false; const int s=vcu&7; u.bh=vcu>>3; u.qb=(i==0)?s:(i==1)?15-s:(i==2)?16+s:31-s; return true; }
  __device__ __forceinline__ void a_ready(const AttnUnit&)const{}
  __device__ __forceinline__ void done(const AttnUnit&)const{}
};
template<class Sched,int THRL=8> __device__ __forceinline__ void attn_phase(char*lds,const AttnTensors&T,const Sched&S){
  AttnUnit u;
  for(int i=0;S.next(i,u);++i){ S.a_ready(u); attn_unit<THRL>(u.bh/NHEAD,u.bh%NHEAD,u.qb,T.Q,T.K,T.V,T.O,lds); S.done(u); }
}
#undef SBAR
#undef WAIT_BAR
}


namespace cg = cooperative_groups;
#define LAS __attribute__((address_space(3)))
typedef unsigned short bf16;
typedef float f32x4 __attribute__((ext_vector_type(4)));
typedef unsigned u32x4 __attribute__((ext_vector_type(4)));
typedef unsigned u32x2 __attribute__((ext_vector_type(2)));
typedef short bf16x8 __attribute__((ext_vector_type(8)));
using pg8::cvt_pk_bf16; using pg8::bflo; using pg8::bfhi; using pg8::pack8; using pg8::unpack8;

constexpr int SEQ = 8192, M = 16384, DMODEL = 1024, DEPTH = 4, INC = 9728, DFF = 2816, NWAVES = 8;
#ifndef ATTREP
#define ATTREP 0
#endif
#ifndef CONVREP
#define CONVREP 0
#endif
#ifndef DILREP
#define DILREP 0
#endif
#ifndef USE_XBAR
#define USE_XBAR 1
#endif
#ifndef SEAM_FENCES
#define SEAM_FENCES 0
#endif
#ifndef XSEAM
#define XSEAM 0
#endif
#ifndef RPT
#define RPT 0
#endif
#ifndef PHMASK
#define PHMASK 0xBEF
#endif
constexpr int NPH = 12;
constexpr size_t MiB = 1u << 20;
constexpr size_t WS_WIN = 0, WS_WBRA = 19 * MiB, WS_WBRB = 20 * MiB, WS_WBRC = 21 * MiB, WS_WGLU = 22 * MiB, WS_WOUT = 23 * MiB, WS_WUP = 25 * MiB, WS_WDOWN = 36 * MiB,
                 WS_WS1 = 42 * MiB, WS_WS2 = 66 * MiB, WS_L32 = 70 * MiB, WS_ROPEA = 71 * MiB, WS_ROPEB = 72 * MiB, WS_X = 74 * MiB, WS_H = 138 * MiB,
                 WS_QA = 170 * MiB, WS_KA = 186 * MiB, WS_VA = 202 * MiB, WS_QB = 218 * MiB, WS_KB = 266 * MiB, WS_VB = 314 * MiB, WS_CU = 362 * MiB, WS_GATES = 378 * MiB,
                 WS_OG = 474 * MiB, WS_LSE = 522 * MiB, WS_OA = 523 * MiB, WS_Y = 539 * MiB, WS_E = 571 * MiB, WS_CARRY = 579 * MiB, WS_END = 583 * MiB;
constexpr size_t WS_O16 = WS_H, WS_Z = WS_QA, WS_OC = WS_KA, WS_OB = WS_VA, WS_MF = WS_QB, WS_MB = WS_VB;
constexpr size_t WS_FA = 170 * MiB, WS_FB = 258 * MiB, WS_ACT = 346 * MiB;
constexpr int LDS_BYTES = 147456, XCH_OFF = 131072, XBST_OFF = 139264;
constexpr size_t WS_CTL = WS_END, CTL_BYTES = 16384, WS_SSQ = WS_END + MiB, WS_TOTAL = WS_END + 2 * MiB;

struct Args { const void* in[33]; float* out; unsigned char* ws; int ph_lo, ph_hi; };

using pg8::shx;
__device__ __forceinline__ float wave_sum(float v, int lane) {
#pragma unroll
    for (int o = 1; o < 64; o <<= 1) v += shx(v, o, lane);
    return v;
}
__device__ __forceinline__ int inproj_col(int n) {
    const int pn = n >> 8, p = n & 255, bj = p >> 7, wc = (p >> 5) & 3, fq = (p >> 3) & 3, j = p & 7;
    if (pn < 4) { const int d = bj ? 32 + 8 * fq + j : (j < 2 ? 2 * fq + j : (j < 4 ? 8 + 2 * fq + (j - 2) : 16 + 4 * fq + (j - 4))); return pn * 256 + wc * 64 + d; }
    if (pn >= 6 && pn < 18) { const int head = wc >> 1, w = wc & 1; const int d = w ? 64 + 32 * bj + 8 * fq + j : (bj ? 32 + 8 * fq + j : (j < 4 ? 4 * fq + j : 16 + 4 * fq + (j - 4))); return pn * 256 + head * 128 + d; }
    return n;
}
__device__ __forceinline__ int srccol(int mapid, int n) {
    if (mapid == 1) return inproj_col(n);
    if (mapid == 2) { const int pn = n >> 8, p = n & 255; return (p >> 7) * DFF + pn * 128 + (p & 127); }
    return n;
}
__device__ __forceinline__ void transpose_item(const float* W, int K, int N, bf16* WT, int mapid, LAS float* scr, int item, int lane, int ldw = 0, int koff = 0) {
    if (ldw == 0) ldw = K;
    const int nblk = N / 32, kb = item / nblk, nb = item % nblk, k0 = 64 * kb, n0 = 32 * nb;
    const int sc = srccol(mapid, n0 + (lane & 31));
    float tv[32];
#pragma unroll
    for (int i = 0; i < 32; ++i) tv[i] = W[(size_t)(k0 + 2 * i + (lane >> 5)) * N + sc];
#pragma unroll
    for (int i = 0; i < 32; ++i) scr[(2 * i + (lane >> 5)) * 33 + (lane & 31)] = tv[i];
    asm volatile("s_waitcnt lgkmcnt(0)" ::: "memory");
    const int c = lane & 7;
#pragma unroll
    for (int j = 0; j < 4; ++j) { const int n = (lane >> 3) + 8 * j; const LAS float* s = scr + (8 * c) * 33 + n;
        u32x4 o; o.x = cvt_pk_bf16(s[0 * 33], s[1 * 33]); o.y = cvt_pk_bf16(s[2 * 33], s[3 * 33]); o.z = cvt_pk_bf16(s[4 * 33], s[5 * 33]); o.w = cvt_pk_bf16(s[6 * 33], s[7 * 33]);
        *(u32x4*)(WT + (size_t)(n0 + n) * ldw + koff + k0 + 8 * c) = o; }
    asm volatile("s_waitcnt lgkmcnt(0)" ::: "memory");
}
__device__ __forceinline__ void rms_row(const float* xrow, const float* g, bf16* orow, float* ssq4, int lane) {
    const f32x4* xr = (const f32x4*)xrow + lane; const f32x4* gr = (const f32x4*)g + lane;
    f32x4 v[4]; float s = 0.f;
#pragma unroll
    for (int j = 0; j < 4; ++j) { v[j] = xr[64 * j]; s += (v[j].x * v[j].x + v[j].y * v[j].y) + (v[j].z * v[j].z + v[j].w * v[j].w); }
    const float tot = wave_sum(s, lane);
    if (lane < 4) ssq4[lane] = (lane == 0) ? tot : 0.f;
    u32x2* o8 = (u32x2*)orow + lane;
#pragma unroll
    for (int j = 0; j < 4; ++j) { const f32x4 gg = gr[64 * j]; u32x2 w; w.x = cvt_pk_bf16(v[j].x * gg.x, v[j].y * gg.y); w.y = cvt_pk_bf16(v[j].z * gg.z, v[j].w * gg.w); o8[64 * j] = w; }
}

#define XB_TMO      128
#define XB_XCNT(j)  (256  + 64 * (j))
#define XB_XSUB(j)  (1280 + 64 * (j))
#define XB_XGEN(j)  (2304 + 64 * (j))
#define XB_TOP      3328
#define XB_TOPGEN   3392
#define XCD_BAR_WORDS 3456
#define XB_SPIN_CAP (1u << 18)

__device__ __forceinline__ unsigned xb_ld(unsigned* p)              { return __hip_atomic_load(p, __ATOMIC_RELAXED, __HIP_MEMORY_SCOPE_AGENT); }
__device__ __forceinline__ unsigned xb_add(unsigned* p, unsigned v) { return __hip_atomic_fetch_add(p, v, __ATOMIC_RELAXED, __HIP_MEMORY_SCOPE_AGENT); }
__device__ __forceinline__ unsigned xb_xcc_id() { return (unsigned)__builtin_amdgcn_s_getreg((3 << 11) | 20) & 0xFu; }
#define XB_SPIN(cond, bar) do { unsigned _sp = 0; while (cond) { __builtin_amdgcn_s_sleep(1); \
    if ((++_sp & 255u) == 0u) { if (xb_ld(&(bar)[XB_TMO])) break; if (_sp > XB_SPIN_CAP) { atomicAdd(&(bar)[XB_TMO], 1u); break; } } } } while (0)

struct XcdBarrier {
    unsigned* bar; unsigned x;
    volatile LAS unsigned* st;
};

__device__ __forceinline__ XcdBarrier xcd_barrier_post(unsigned* bar, volatile LAS unsigned* st) {
    XcdBarrier b; b.bar = bar; b.x = xb_xcc_id(); b.st = st;
    if (threadIdx.x == 0) (void)xb_add(&bar[XB_XCNT(b.x)], 1u);
    return b;
}
__device__ __forceinline__ void xcd_barrier_complete(unsigned* bar, unsigned x, unsigned& nloc, unsigned& nx) {
    const unsigned G = gridDim.x * gridDim.y * gridDim.z;
    unsigned sum, cnt, mine, sp = 0u;
    for (;;) {
        sum = 0u; cnt = 0u; mine = 0u;
#pragma unroll
        for (unsigned j = 0; j < 16; ++j) { const unsigned c = xb_ld(&bar[XB_XCNT(j)]); sum += c; cnt += (c > 0u) ? 1u : 0u; mine = (j == x) ? c : mine; }
        if (sum == G) break;
        __builtin_amdgcn_s_sleep(1);
        if ((++sp & 255u) == 0u) { if (xb_ld(&bar[XB_TMO])) break; if (sp > XB_SPIN_CAP) { atomicAdd(&bar[XB_TMO], 1u); break; } }
    }
    nloc = mine > 0u ? mine : 1u; nx = cnt > 0u ? cnt : 1u;
}

__device__ __forceinline__ void xcd_barrier(const XcdBarrier& b) {
    asm volatile("s_waitcnt vmcnt(0)" ::: "memory");
    __syncthreads();
    if (threadIdx.x == 0) {
        unsigned* bar = b.bar;
        __builtin_amdgcn_s_waitcnt(0);
        unsigned nloc = b.st[0], nx = b.st[1];
        if (nloc == 0u) { xcd_barrier_complete(bar, b.x, nloc, nx); b.st[0] = nloc; b.st[1] = nx; }
        const unsigned old = xb_add(&bar[XB_XSUB(b.x)], 1u);
        const unsigned gen = old / nloc;
        if (old + 1u == (gen + 1u) * nloc) {
            __builtin_amdgcn_fence(__ATOMIC_RELEASE, "agent");
            asm volatile("s_waitcnt vmcnt(0)" ::: "memory");
            const unsigned og = xb_add(&bar[XB_TOP], 1u);
            const unsigned tg = og / nx;
            if (og + 1u == (tg + 1u) * nx) xb_add(&bar[XB_TOPGEN], 1u);
            else XB_SPIN(xb_ld(&bar[XB_TOPGEN]) == tg, bar);
            __builtin_amdgcn_fence(__ATOMIC_ACQUIRE, "agent");
            xb_add(&bar[XB_XGEN(b.x)], 1u);
            asm volatile("s_waitcnt vmcnt(0)" ::: "memory");
        } else {
            XB_SPIN(xb_ld(&bar[XB_XGEN(b.x)]) == gen, bar);
            __builtin_amdgcn_fence(__ATOMIC_ACQUIRE, "agent");
            asm volatile("s_waitcnt vmcnt(0)" ::: "memory");
        }
    }
    __syncthreads();
}

__device__ __forceinline__ void ssm_build(int g, const float* a_re, const float* a_im, const float* log_dt, const float* b_re, const float* b_im, const float* c_re, const float* c_im,
                                          bf16* W1, bf16* W2, float* L32, LAS float* sm, int tid, int half) {
    LAS float* pw_re = sm; LAS float* pw_im = sm + 2112; LAS float* bb_re = sm + 4224; LAS float* bb_im = sm + 5248; LAS float* cc_re = sm + 6272; LAS float* cc_im = sm + 7296; LAS float* kern = sm + 8320;
    const float dt = expf(log_dt[g]);
    for (int idx = tid; idx < 33 * 64; idx += 512) { const int tau = idx >> 6, p = idx & 63; const float are = a_re[g * 64 + p], aim = a_im[g * 64 + p];
        const float mag = expf(are * dt * (float)tau); float s, c; sincosf(aim * dt * (float)tau, &s, &c); pw_re[idx] = mag * c; pw_im[idx] = mag * s; }
    __syncthreads();
    for (int idx = tid; idx < 1024; idx += 512) { const int p = idx >> 4; const float are = a_re[g * 64 + p], aim = a_im[g * 64 + p];
        const float nre = pw_re[64 + p] - 1.0f, nim = pw_im[64 + p], den = are * are + aim * aim;
        const float fre = (nre * are + nim * aim) / den, fim = (nim * are - nre * aim) / den;
        const float br = b_re[(size_t)g * 1024 + idx], bi = b_im[(size_t)g * 1024 + idx];
        bb_re[idx] = fre * br - fim * bi; bb_im[idx] = fre * bi + fim * br;
        cc_re[idx] = c_re[(size_t)g * 1024 + idx]; cc_im[idx] = c_im[(size_t)g * 1024 + idx]; }
    __syncthreads();
    for (int idx = tid; idx < 8192; idx += 512) { const int tau = idx >> 8, c = (idx >> 4) & 15, c2 = idx & 15; float acc = 0.f;
        for (int p = 0; p < 64; ++p) { const float cr = cc_re[c * 64 + p], ci = cc_im[c * 64 + p], pr = pw_re[tau * 64 + p], pi = pw_im[tau * 64 + p];
            const float xr = cr * pr - ci * pi, xi = cr * pi + ci * pr; acc += xr * bb_re[p * 16 + c2] - xi * bb_im[p * 16 + c2]; }
        kern[idx] = acc; }
    __syncthreads();
    bf16* W1g = W1 + (size_t)g * 768 * 512; bf16* W2g = W2 + (size_t)g * 512 * 128;
    for (int idx = tid + half * (768 * 32); idx < (half + 1) * (768 * 32); idx += 512) { const int n = idx >> 6, q = idx & 63, s = q >> 1, c0 = (q & 1) * 8; float v[8];
        if (n < 512) { const int t = n >> 4, c = n & 15;
#pragma unroll
            for (int j = 0; j < 8; ++j) v[j] = (s <= t) ? kern[(t - s) * 256 + c * 16 + c0 + j] : 0.f; }
        else if (n < 640) { const int e = n - 512, p = e & 63; const float pr = pw_re[(31 - s) * 64 + p], pi = pw_im[(31 - s) * 64 + p];
#pragma unroll
            for (int j = 0; j < 8; ++j) { const float br = bb_re[p * 16 + c0 + j], bi = bb_im[p * 16 + c0 + j]; v[j] = (e < 64) ? (pr * br - pi * bi) : (pr * bi + pi * br); } }
        else {
#pragma unroll
            for (int j = 0; j < 8; ++j) v[j] = 0.f; }
        u32x4 o; o.x = cvt_pk_bf16(v[0], v[1]); o.y = cvt_pk_bf16(v[2], v[3]); o.z = cvt_pk_bf16(v[4], v[5]); o.w = cvt_pk_bf16(v[6], v[7]);
        *(u32x4*)(W1g + (size_t)n * 512 + q * 8) = o; }
    for (int idx = tid + half * 4096; idx < (half + 1) * 4096; idx += 512) { const int n = idx >> 4, q = idx & 15, t = n >> 4, c = n & 15; float v[8];
#pragma unroll
        for (int j = 0; j < 8; ++j) { const int k = q * 8 + j, p = k & 63; const float cr = cc_re[c * 64 + p], ci = cc_im[c * 64 + p], pr = pw_re[(t + 1) * 64 + p], pi = pw_im[(t + 1) * 64 + p];
            v[j] = (k < 64) ? (cr * pr - ci * pi) : -(cr * pi + ci * pr); }
        u32x4 o; o.x = cvt_pk_bf16(v[0], v[1]); o.y = cvt_pk_bf16(v[2], v[3]); o.z = cvt_pk_bf16(v[4], v[5]); o.w = cvt_pk_bf16(v[6], v[7]);
        *(u32x4*)(W2g + (size_t)n * 128 + q * 8) = o; }
    if (half == 0 && tid < 64) { L32[(g * 64 + tid) * 2] = pw_re[32 * 64 + tid]; L32[(g * 64 + tid) * 2 + 1] = pw_im[32 * 64 + tid]; }
    __syncthreads();
}

constexpr int KSTR = 272, VSTR = 528, DIL_VT_OFF = 256 * KSTR;
struct DilRegs { u32x4 k[8], v[8]; bf16x8 q[4]; };
__device__ __forceinline__ void dil_load(int it, const bf16* qb, const bf16* kb, const bf16* vb, DilRegs& R, int tid) {
    const int lane = tid & 63, w = __builtin_amdgcn_readfirstlane(tid >> 6), fr = lane & 15, fq = lane >> 4;
    const int b = it / 768; int r = it % 768; const int g = r >> 8; r &= 255; const int h = r >> 6, blk = r & 63;
    const int dl = 2 * g, dil = 1 << dl, res = blk & (dil - 1), n = blk >> dl;
    const size_t tokbase = (size_t)b * SEQ; const int colbase = g * 512 + h * 128;
#pragma unroll
    for (int i = 0; i < 8; ++i) { const int p = tid + 512 * i, row = p >> 4, c16 = p & 15; const int tk = ((n - 1) * 128 + row) * dil + res; const bool ok = (n > 0 || row >= 128);
        const size_t off = (tokbase + (ok ? tk : 0)) * 1536 + colbase + c16 * 8;
        const u32x4 kk = *(const u32x4*)(kb + off), vv = *(const u32x4*)(vb + off);
        R.k[i] = ok ? kk : (u32x4){0u, 0u, 0u, 0u}; R.v[i] = ok ? vv : (u32x4){0u, 0u, 0u, 0u}; }
    const int qtok = (n * 128 + 16 * w + fr) * dil + res;
#pragma unroll
    for (int kk = 0; kk < 4; ++kk) R.q[kk] = *(const bf16x8*)(qb + (tokbase + qtok) * 1536 + colbase + 32 * kk + 8 * fq);
}
__device__ __forceinline__ void dil_stage(const DilRegs& R, LAS unsigned char* L, int tid) {
    LAS unsigned char* Ks = L; LAS unsigned char* Vt = L + DIL_VT_OFF;
#pragma unroll
    for (int i = 0; i < 8; ++i) { const int p = tid + 512 * i, row = p >> 4, c16 = p & 15;
        *(LAS u32x4*)(Ks + row * KSTR + c16 * 16) = R.k[i];
        const u32x4 v = R.v[i]; LAS unsigned char* d = Vt + (c16 * 8) * VSTR + ((row ^ (c16 << 2)) * 2);
        *(LAS unsigned short*)(d + 0 * VSTR) = (unsigned short)(v.x & 0xffffu); *(LAS unsigned short*)(d + 1 * VSTR) = (unsigned short)(v.x >> 16);
        *(LAS unsigned short*)(d + 2 * VSTR) = (unsigned short)(v.y & 0xffffu); *(LAS unsigned short*)(d + 3 * VSTR) = (unsigned short)(v.y >> 16);
        *(LAS unsigned short*)(d + 4 * VSTR) = (unsigned short)(v.z & 0xffffu); *(LAS unsigned short*)(d + 5 * VSTR) = (unsigned short)(v.z >> 16);
        *(LAS unsigned short*)(d + 6 * VSTR) = (unsigned short)(v.w & 0xffffu); *(LAS unsigned short*)(d + 7 * VSTR) = (unsigned short)(v.w >> 16); }
}
__device__ __forceinline__ void dil_compute(int it, const bf16x8 (&qf)[4], bf16* og, float* lse, LAS unsigned char* L, int tid) {
    const int lane = tid & 63, w = __builtin_amdgcn_readfirstlane(tid >> 6), fr = lane & 15, fq = lane >> 4;
    const int b = it / 768; int r = it % 768; const int g = r >> 8; r &= 255; const int h = r >> 6, blk = r & 63;
    const int dl = 2 * g, dil = 1 << dl, res = blk & (dil - 1), n = blk >> dl;
    const size_t tokbase = (size_t)b * SEQ;
    LAS unsigned char* Ks = L; LAS unsigned char* Vt = L + DIL_VT_OFF;
    const int qtok = (n * 128 + 16 * w + fr) * dil + res;
    f32x4 s[9];
#pragma unroll
    for (int bb = 0; bb < 9; ++bb) { s[bb] = (f32x4){0.f, 0.f, 0.f, 0.f};
#pragma unroll
        for (int kk = 0; kk < 4; ++kk) { const bf16x8 kf = *(const LAS bf16x8*)(Ks + (16 * (w + bb) + fr) * KSTR + (32 * kk + 8 * fq) * 2);
            s[bb] = __builtin_amdgcn_mfma_f32_16x16x32_bf16(kf, qf[kk], s[bb], 0, 0, 0); } }
    const int qi = 16 * w + fr; float mx = -INFINITY;
#pragma unroll
    for (int bb = 0; bb < 9; ++bb)
#pragma unroll
        for (int i = 0; i < 4; ++i) { const int j = 16 * (w + bb) + 4 * fq + i; const bool ok = (j >= qi) && (j <= qi + 128) && (n > 0 || j >= 128);
            s[bb][i] = ok ? s[bb][i] : -INFINITY; mx = fmaxf(mx, s[bb][i]); }
    mx = fmaxf(mx, shx(mx, 16, lane)); mx = fmaxf(mx, shx(mx, 32, lane));
    float sum = 0.f;
#pragma unroll
    for (int bb = 0; bb < 9; ++bb)
#pragma unroll
        for (int i = 0; i < 4; ++i) { const float p = __builtin_amdgcn_exp2f(s[bb][i] - mx); s[bb][i] = p; sum += p; }
    sum += shx(sum, 16, lane); sum += shx(sum, 32, lane);
    f32x4 o[8];
#pragma unroll
    for (int db = 0; db < 8; ++db) o[db] = (f32x4){0.f, 0.f, 0.f, 0.f};
#pragma unroll
    for (int pr = 0; pr < 5; ++pr) { const int bA = pr < 4 ? 2 * pr : 7, bB = pr < 4 ? 2 * pr + 1 : 8;
        u32x4 pw; pw.x = pr < 4 ? cvt_pk_bf16(s[bA][0], s[bA][1]) : 0u; pw.y = pr < 4 ? cvt_pk_bf16(s[bA][2], s[bA][3]) : 0u; pw.z = cvt_pk_bf16(s[bB][0], s[bB][1]); pw.w = cvt_pk_bf16(s[bB][2], s[bB][3]);
        const bf16x8 pf = __builtin_bit_cast(bf16x8, pw);
#pragma unroll
        for (int db = 0; db < 8; ++db) { const LAS unsigned char* vr = Vt + (16 * db + fr) * VSTR;
            const int swz = ((2 * db + (fr >> 3)) & 15) << 2;
            const u32x2 va = *(const LAS u32x2*)(vr + ((16 * (w + bA) + 4 * fq) ^ swz) * 2), vc = *(const LAS u32x2*)(vr + ((16 * (w + bB) + 4 * fq) ^ swz) * 2);
            u32x4 vv; vv.x = va.x; vv.y = va.y; vv.z = vc.x; vv.w = vc.y;
            o[db] = __builtin_amdgcn_mfma_f32_16x16x32_bf16(__builtin_bit_cast(bf16x8, vv), pf, o[db], 0, 0, 0); } }
    const float inv = 1.0f / sum; const size_t orow = (size_t)g * M + tokbase + qtok;
#pragma unroll
    for (int db = 0; db < 8; ++db) { u32x2 w2; w2.x = cvt_pk_bf16(o[db][0] * inv, o[db][1] * inv); w2.y = cvt_pk_bf16(o[db][2] * inv, o[db][3] * inv);
        *(u32x2*)(og + orow * 512 + h * 128 + 16 * db + 4 * fq) = w2; }
    if (fq == 0) lse[orow * 4 + h] = (mx + __builtin_amdgcn_logf(sum)) * 0.6931471805599453f;
}

#define Wt_in ((bf16*)(ws + WS_WIN))
#define Wt_bra ((bf16*)(ws + WS_WBRA))
#define Wt_brb ((bf16*)(ws + WS_WBRB))
#define Wt_brc ((bf16*)(ws + WS_WBRC))
#define Wt_glu ((bf16*)(ws + WS_WGLU))
#define Wt_out ((bf16*)(ws + WS_WOUT))
#define Wt_up ((bf16*)(ws + WS_WUP))
#define Wt_down ((bf16*)(ws + WS_WDOWN))
#define Wt_s1 ((bf16*)(ws + WS_WS1))
#define Wt_s2 ((bf16*)(ws + WS_WS2))
#define L32 ((float*)(ws + WS_L32))
#define ropeA ((float*)(ws + WS_ROPEA))
#define ropeB ((float*)(ws + WS_ROPEB))
#define X ((float*)(ws + WS_X))
#define H ((bf16*)(ws + WS_H))
#define QA ((bf16*)(ws + WS_QA))
#define KA ((bf16*)(ws + WS_KA))
#define VA ((bf16*)(ws + WS_VA))
#define QB ((bf16*)(ws + WS_QB))
#define KB ((bf16*)(ws + WS_KB))
#define VB ((bf16*)(ws + WS_VB))
#define CU ((bf16*)(ws + WS_CU))
#define GATES ((bf16*)(ws + WS_GATES))
#define O16 ((bf16*)(ws + WS_O16))
#define OG ((bf16*)(ws + WS_OG))
#define LSE ((float*)(ws + WS_LSE))
#define OA ((bf16*)(ws + WS_OA))
#define OABC ((bf16*)(ws + WS_QB))
#define SSQ ((float*)(ws + WS_SSQ))
#define Y ((bf16*)(ws + WS_Y))
#define EB ((float*)(ws + WS_E))
#define CARRY ((bf16*)(ws + WS_CARRY))
#define Z ((bf16*)(ws + WS_Z))
#define OC ((bf16*)(ws + WS_OC))
#define OB ((bf16*)(ws + WS_OB))
#define MF ((float*)(ws + WS_MF))
#define MB ((bf16*)(ws + WS_MB))
#define FA ((bf16*)(ws + WS_FA))
#define FB ((bf16*)(ws + WS_FB))
#define ACT ((bf16*)(ws + WS_ACT))
__device__ __forceinline__ void scan_item(int b, int g, int pg, int lane, const float* L32_, const float* EB_, bf16* CARRY_) {
    const int p = pg * 4 + (lane & 3), seg = lane >> 2;
    const float lr = L32_[(g * 64 + p) * 2], li = L32_[(g * 64 + p) * 2 + 1];
    float er[16], ei[16];
#pragma unroll
    for (int j = 0; j < 16; ++j) { const float* e = EB_ + ((size_t)g * 512 + b * 256 + seg * 16 + j) * 128 + p; er[j] = e[0]; ei[j] = e[64]; }
    float sr = 0.f, si = 0.f;
#pragma unroll
    for (int j = 0; j < 16; ++j) { const float nr = lr * sr - li * si + er[j], ni = lr * si + li * sr + ei[j]; sr = nr; si = ni; }
    float pr = lr, pi = li;
#pragma unroll
    for (int q = 0; q < 4; ++q) { const float nr = pr * pr - pi * pi, ni = 2.f * pr * pi; pr = nr; pi = ni; }
#pragma unroll
    for (int d = 1; d < 16; d <<= 1) {
        const int src = (lane - 4 * d) & 63;
        const float qr = __int_as_float(__builtin_amdgcn_ds_bpermute(src << 2, __float_as_int(sr))), qi = __int_as_float(__builtin_amdgcn_ds_bpermute(src << 2, __float_as_int(si)));
        if (seg >= d) { sr += pr * qr - pi * qi; si += pr * qi + pi * qr; }
        const float nr = pr * pr - pi * pi, ni = 2.f * pr * pi; pr = nr; pi = ni;
    }
    float cr = __int_as_float(__builtin_amdgcn_ds_bpermute(((lane - 4) & 63) << 2, __float_as_int(sr))), ci = __int_as_float(__builtin_amdgcn_ds_bpermute(((lane - 4) & 63) << 2, __float_as_int(si)));
    if (seg == 0) { cr = 0.f; ci = 0.f; }
#pragma unroll
    for (int j = 0; j < 16; ++j) { bf16* c = CARRY_ + ((size_t)g * 512 + b * 256 + seg * 16 + j) * 128 + p;
        c[0] = (bf16)(cvt_pk_bf16(cr, 0.f) & 0xffffu); c[64] = (bf16)(cvt_pk_bf16(ci, 0.f) & 0xffffu);
        const float nr = lr * cr - li * ci + er[j], ni = lr * ci + li * cr + ei[j]; cr = nr; ci = ni; }
}
#define CONV_EARLY(LL, GWX, NGWX) CONV_EARLY_R(LL, GWX, NGWX, 0, 1 << 30)
#define CONV_EARLY_R(LL, GWX, NGWX, IT0, IT1) do { LAS float* scr = (LAS float*)(L + wave * 16384); \
        constexpr int I_IN = 16 * 304, I_BR = 8 * 32, I_GLU = 8 * 16, I_OUT = 16 * 32; constexpr int NIT = I_IN + 3 * I_BR + I_GLU + I_OUT; \
        for (int it = (IT0) + (GWX); it < NIT && it < (IT1); it += (NGWX)) { int r = it; \
            if (r < I_IN) { transpose_item(INF(3) + (size_t)(LL) * 1024 * INC, 1024, INC, Wt_in, 1, scr, r, lane); continue; } r -= I_IN; \
            if (r < I_BR) { transpose_item(INF(12) + (size_t)(LL) * 512 * 1024, 512, 1024, Wt_bra, 0, scr, r, lane, 1536, 0); continue; } r -= I_BR; \
            if (r < I_BR) { transpose_item(INF(15) + (size_t)(LL) * 512 * 1024, 512, 1024, Wt_bra, 0, scr, r, lane, 1536, 512); continue; } r -= I_BR; \
            if (r < I_BR) { transpose_item(INF(26) + (size_t)(LL) * 512 * 1024, 512, 1024, Wt_bra, 0, scr, r, lane, 1536, 1024); continue; } r -= I_BR; \
            if (r < I_GLU) { transpose_item(INF(24) + (size_t)(LL) * 512 * 512, 512, 512, Wt_glu, 0, scr, r, lane); continue; } r -= I_GLU; \
            transpose_item(INF(27) + (size_t)(LL) * 1024 * 1024, 1024, 1024, Wt_out, 0, scr, r, lane); } } while (0)
#define CONV_LATE(LL, GWX, NGWX) do { LAS float* scr = (LAS float*)(L + wave * 16384); \
        constexpr int I_UP = 16 * 176, I_DOWN = 44 * 32; \
        for (int it = (GWX); it < I_UP + I_DOWN; it += (NGWX)) { \
            if (it < I_UP) transpose_item(INF(29) + (size_t)(LL) * 1024 * 2 * DFF, 1024, 2 * DFF, Wt_up, 2, scr, it, lane); \
            else transpose_item(INF(32) + (size_t)(LL) * DFF * 1024, DFF, 1024, Wt_down, 0, scr, it - I_UP, lane); } } while (0)
#define SSM_BUILD(LL, GG, HH) ssm_build((GG), INF(16) + (LL) * 2048, INF(17) + (LL) * 2048, INF(18) + (LL) * 32, INF(19) + (size_t)(LL) * 32768, INF(20) + (size_t)(LL) * 32768, INF(21) + (size_t)(LL) * 32768, INF(22) + (size_t)(LL) * 32768, Wt_s1, Wt_s2, L32, (LAS float*)L, tid, (HH))
__global__ void __launch_bounds__(NWAVES * 64, 2) fwd(Args args) {
    extern __shared__ __attribute__((aligned(16))) unsigned char lds[];
    cg::grid_group grid = cg::this_grid();
    LAS unsigned char* L = (LAS unsigned char*)lds;
#if USE_XBAR
    if (threadIdx.x < 2) ((volatile LAS unsigned*)(L + XBST_OFF))[threadIdx.x] = 0u;
    __syncthreads();
    (void)xcd_barrier_post((unsigned*)(args.ws + WS_CTL), (volatile LAS unsigned*)(L + XBST_OFF));
    grid.sync();
#endif
#define INF(k) ((const float*)args.in[(k) + zz])
    for (int it2 = args.ph_lo * 2; it2 < args.ph_hi * 2; ++it2) {
        const int ph = it2 >> 1; const int l = ph / NPH, k = ph % NPH;
        if ((it2 & 1) && !((RPT >> k) & 1)) continue;
        int zz; asm volatile("s_mov_b32 %0, 0" : "=s"(zz));
        unsigned char* const ws = args.ws + zz;
        const int G = (int)gridDim.x + zz, bx = (int)blockIdx.x + zz, vcu = (G % 8 == 0) ? (bx % 8) * (G / 8) + bx / 8 : bx; const int NGW = G * NWAVES;
#define PHASE_IDS int tid = threadIdx.x; asm volatile("" : "+v"(tid)); const int lane = tid & 63, wave = __builtin_amdgcn_readfirstlane(tid >> 6); const int gw = vcu * NWAVES + wave; (void)lane; (void)gw;
        const float* xin = (l == 0) ? INF(0) : X;
        if (k == 0 && l == 0 && (PHMASK & 1)) {
            PHASE_IDS
            if (vcu < 64) SSM_BUILD(0, vcu >> 1, vcu & 1);
            CONV_EARLY(0, gw, NGW);
            if (l == 0) {
                const int* pos = (const int*)args.in[1 + zz];
                for (int idx = (vcu * 512 + tid); idx < M * 8; idx += G * 512) { const int m = idx >> 3, i = idx & 7; const float inv = expf(-(float)(2 * i) / 16.0f * 13.122363377404328f);
                    float s, c; sincosf((float)pos[m] * inv, &s, &c); ropeA[idx * 2] = c; ropeA[idx * 2 + 1] = s; }
                for (int idx = (vcu * 512 + tid); idx < M * 16; idx += G * 512) { const int m = idx >> 4, i = idx & 15; const float inv = expf(-(float)(2 * i) / 32.0f * 13.122363377404328f);
                    float s, c; sincosf((float)pos[m] * inv, &s, &c); ropeB[idx * 2] = c; ropeB[idx * 2 + 1] = s; }
            }
            if (l == 0) for (int m = gw; m < M; m += NGW) rms_row(xin + (size_t)m * 1024, INF(2) + l * 1024, H + (size_t)m * 1024, SSQ + (size_t)m * 4, lane);
        } else if (k == 1 && (PHMASK & (1 << 1))) {
            pg8::Gemm g{(const char*)H, (const char*)Wt_in, 1024, 2048, 32, 128};
            pg8::StaticOrder S; S.init(M, INC, G, bx, (size_t)256 * 2048, (size_t)256 * 1024 * 2);
            pg8::EpiInProj E{QA, KA, VA, QB, KB, VB, CU, GATES, INF(5) + l * 64, INF(6) + l * 64, INF(13) + l * 128, INF(14) + l * 128, INF(4) + l * 3072, ropeA, ropeB, (LAS float*)(L + XCH_OFF), SSQ};
            pg8::gemm_phase<pg8::EpiInProj, pg8::StaticOrder, true, true>(L, g, S, E);
            if (bx >= 128) { PHASE_IDS for (int rep_ = 0; rep_ <= CONVREP; ++rep_) CONV_LATE(l, (bx - 128) * NWAVES + wave, 128 * NWAVES); }
        } else if (k == 2 && (PHMASK & (1 << 2))) {
            PHASE_IDS
            {
                const attn_body::AttnTensors AT{(const attn_body::bf16*)QA, (const attn_body::bf16*)KA, (const attn_body::bf16*)VA, (attn_body::bf16*)O16};
                const attn_body::StaticOrder S(G, bx);
                for (int rep_ = 0; rep_ <= ATTREP; ++rep_) attn_body::attn_phase<attn_body::StaticOrder>((char*)lds, AT, S);
            }
            __syncthreads();
            for (int rep = 0; rep <= DILREP; ++rep) {
                const bool clsA = vcu >= 192, clsB = !clsA && (vcu % 3) == 2;
                const int dbase = clsA ? 768 + (vcu - 192) : (clsB ? 1280 + vcu / 3 : (vcu / 3) * 2 + (vcu % 3)), dstep = (clsA || clsB) ? 64 : 128, dend = clsA ? 1280 : (clsB ? 1536 : 768);
                DilRegs R; dil_load(dbase, QB, KB, VB, R, tid);
                for (int it = dbase; it < dend; it += dstep) {
                    dil_stage(R, L, tid);
                    bf16x8 qf[4];
#pragma unroll
                    for (int kk = 0; kk < 4; ++kk) qf[kk] = R.q[kk];
                    __syncthreads();
                    if (it + dstep < dend) dil_load(it + dstep, QB, KB, VB, R, tid);
                    dil_compute(it, qf, OG, LSE, L, tid);
                    __syncthreads();
                }
            }
            {
                pg8::Gemm g{(const char*)CU, (const char*)Wt_s1, 512, 1024, 32, 128};
                pg8::GroupOrder S; S.init(2, 3, G, vcu, (size_t)256 * 1024, (size_t)256 * 512 * 2, (size_t)16384 * 16 * 2, (size_t)768 * 512 * 2);
                pg8::EpiSsm1 E{Y, EB};
                pg8::gemm_phase<pg8::EpiSsm1, pg8::GroupOrder, true, true>(L, g, S, E);
                if (vcu < 192 && (vcu % 3) == 2) {
                    asm volatile("s_waitcnt vmcnt(0)" ::: "memory"); __syncthreads();
                    for (int pg = wave; pg < 16; pg += NWAVES) scan_item((vcu % 6) / 3, vcu / 6, pg, lane, L32, EB, CARRY);
                }
            }
        } else if (k == 3 && (PHMASK & (1 << 3))) {
            PHASE_IDS
            {
                const float lam_init = 0.8f - 0.6f * expf(-0.3f * (float)l);
                const float d1 = wave_sum(INF(7)[l * 64 + lane] * INF(8)[l * 64 + lane], lane), d2 = wave_sum(INF(9)[l * 64 + lane] * INF(10)[l * 64 + lane], lane);
                const float lam = expf(d1) - expf(d2) + lam_init;
                const int head = lane >> 4, e8 = (lane & 15) * 8;
                f32x4 sg0 = *(const f32x4*)(INF(11) + l * 128 + e8), sg1 = *(const f32x4*)(INF(11) + l * 128 + e8 + 4);
                sg0 *= (1.0f - lam_init); sg1 *= (1.0f - lam_init);
                const int CSPLIT = 4864;
                const int half_ = (bx < 128) ? 0 : 1, gwh = (bx & 127) * NWAVES + wave;
                for (int m = (half_ ? CSPLIT : 0) + gwh; m < (half_ ? M : CSPLIT); m += 128 * NWAVES) {
                    f32x4 a0, a1, b0, b1; unpack8(*(const u32x4*)(O16 + (size_t)m * 1024 + head * 256 + e8), a0, a1); unpack8(*(const u32x4*)(O16 + (size_t)m * 1024 + head * 256 + 128 + e8), b0, b1);
                    a0 -= lam * b0; a1 -= lam * b1;
                    float ss = 0.f;
#pragma unroll
                    for (int e = 0; e < 4; ++e) ss += a0[e] * a0[e] + a1[e] * a1[e];
                    ss += shx(ss, 1, lane); ss += shx(ss, 2, lane); ss += shx(ss, 4, lane); ss += shx(ss, 8, lane);
                    const float rs = __builtin_amdgcn_rsqf(ss * (1.0f / 128.0f) + 1e-6f);
                    *(u32x4*)(OABC + (size_t)m * 1536 + head * 128 + e8) = pack8(a0 * rs * sg0, a1 * rs * sg1);
                    const float l0 = LSE[((size_t)0 * M + m) * 4 + head], l1 = LSE[((size_t)1 * M + m) * 4 + head], l2 = LSE[((size_t)2 * M + m) * 4 + head];
                    const float lm = fmaxf(l0, fmaxf(l1, l2)); const float w0 = __expf(l0 - lm), w1 = __expf(l1 - lm), w2 = __expf(l2 - lm); const float wi = 1.0f / (w0 + w1 + w2);
                    f32x4 p0, p1, q0, q1, r0, r1;
                    unpack8(*(const u32x4*)(OG + ((size_t)0 * M + m) * 512 + head * 128 + e8), p0, p1); unpack8(*(const u32x4*)(OG + ((size_t)1 * M + m) * 512 + head * 128 + e8), q0, q1);
                    unpack8(*(const u32x4*)(OG + ((size_t)2 * M + m) * 512 + head * 128 + e8), r0, r1);
                    p0 = (p0 * w0 + q0 * w1 + r0 * w2) * wi; p1 = (p1 * w0 + q1 * w1 + r1 * w2) * wi;
                    *(u32x4*)(OABC + (size_t)m * 1536 + 512 + head * 128 + e8) = pack8(p0, p1);
                }
            }
            {
                pg8::Gemm g{(const char*)CARRY, (const char*)Wt_s2, 128, 256, 32, 128};
                pg8::GroupOrder S; S.init(2, 2, G, bx, (size_t)256 * 256, (size_t)256 * 128 * 2, (size_t)512 * 128 * 2, (size_t)512 * 128 * 2);
                pg8::EpiSsm2 E{Y, CU, INF(23) + l * 512, Z};
                pg8::gemm_phase<pg8::EpiSsm2, pg8::GroupOrder, true, true>(L, g, S, E);
            }
        } else if (k == 4 && (PHMASK & (1 << 4))) {
            pg8::Gemm g{(const char*)CARRY, (const char*)Wt_s2, 128, 8192, 32, 128};
            pg8::GroupOrder S; S.init(2, 2, G, bx, (size_t)256 * 8192, (size_t)256 * 128 * 2, 256, (size_t)512 * 128 * 2);
            pg8::EpiSsm2 E{Y, CU, INF(23) + l * 512, Z};
            pg8::gemm_phase<pg8::EpiSsm2, pg8::GroupOrder, true, true>(L, g, S, E);
        } else if (k == 5 && (PHMASK & (1 << 5))) {
            pg8::Gemm g{(const char*)Z, (const char*)Wt_glu, 512, 1024, 32, 128};
            pg8::StaticOrder S; S.init(M, 512, G, bx, (size_t)256 * 1024, (size_t)256 * 512 * 2);
            pg8::EpiGlu E{Z, INF(25) + l * 512, OABC + 1024, 1536};
            pg8::gemm_phase<pg8::EpiGlu, pg8::StaticOrder, true, true>(L, g, S, E);
            if (bx >= 128 && l + 1 < DEPTH) { PHASE_IDS
                if (bx < 192) SSM_BUILD(l + 1, (bx - 128) >> 1, (bx - 128) & 1); else CONV_EARLY_R(l + 1, (bx - 192) * NWAVES + wave, 64 * NWAVES, 0, 1536); }
        } else if (k == 6 && (PHMASK & (1 << 6))) {
            pg8::Gemm g{(const char*)OABC, (const char*)Wt_bra, 1536, 3072, 32, 128};
            pg8::StaticOrder S; S.init(M, 1024, G, bx, (size_t)256 * 3072, (size_t)256 * 1536 * 2);
            pg8::EpiMergeF E{GATES, MB};
            pg8::gemm_phase<pg8::EpiMergeF, pg8::StaticOrder, true, true>(L, g, S, E);
        } else if (k == 7 && (PHMASK & (1 << 7))) {
            pg8::Gemm g{(const char*)MB, (const char*)Wt_out, 1024, 2048, 32, 128};
            pg8::StaticOrder S; S.init(M, 1024, G, bx, (size_t)256 * 2048, (size_t)256 * 1024 * 2);
            if ((RPT & 0x80) && !(it2 & 1)) { pg8::EpiResid E{xin, (float*)(ws + WS_OG)}; pg8::gemm_phase<pg8::EpiResid, pg8::StaticOrder, true, true>(L, g, S, E); } else {
            pg8::EpiResidN E{xin, X, INF(28) + l * 1024, H, SSQ, (LAS float*)(L + XCH_OFF)};
            pg8::gemm_phase<pg8::EpiResidN, pg8::StaticOrder, true, true>(L, g, S, E); }
        } else if (k == 8 && (PHMASK & (1 << 8))) {
            PHASE_IDS
        } else if (k == 9 && (PHMASK & (1 << 9))) {
            pg8::Gemm g{(const char*)H - 2 * 2048, (const char*)Wt_up, 1024, 2048, 32, 128};
            pg8::StaticOrder S; S.init_tiles(65, 22, G, bx, (size_t)254 * 2048, (size_t)256 * 1024 * 2);
            pg8::EpiUpConv E{ACT, SSQ, INF(30) + (size_t)l * 3 * DFF, INF(31) + (size_t)l * DFF, (LAS float*)(L + XCH_OFF)};
            pg8::gemm_phase<pg8::EpiUpConv, pg8::StaticOrder, true, true>(L, g, S, E);
            if (bx >= 150 && l + 1 < DEPTH) { PHASE_IDS for (int rep_ = 0; rep_ <= CONVREP; ++rep_) { CONV_EARLY_R(l + 1, (bx - 150) * NWAVES + wave, 106 * NWAVES, 1536, 1 << 30); } }
        } else if (k == 10 && (PHMASK & (1 << 10))) {
            PHASE_IDS
            const float* cw = INF(30) + (size_t)l * 3 * DFF; const float* cb = INF(31) + (size_t)l * DFF;
            for (int it = vcu * 512 + tid; it < 2048 * 352; it += G * 512) {
                const int cc = it % 352, rr = it / 352, t0 = rr * 8, col = cc * 8;
                u32x4 ra[10], rb[8];
                const bool first = (t0 & (SEQ - 1)) == 0;
                ra[0] = first ? (u32x4){0u, 0u, 0u, 0u} : *(const u32x4*)(FA + (size_t)(t0 - 2) * DFF + col);
                ra[1] = first ? (u32x4){0u, 0u, 0u, 0u} : *(const u32x4*)(FA + (size_t)(t0 - 1) * DFF + col);
#pragma unroll
                for (int t = 0; t < 8; ++t) { ra[t + 2] = *(const u32x4*)(FA + (size_t)(t0 + t) * DFF + col); rb[t] = *(const u32x4*)(FB + (size_t)(t0 + t) * DFF + col); }
                const f32x4 w0a = *(const f32x4*)(cw + col), w0b = *(const f32x4*)(cw + col + 4), w1a = *(const f32x4*)(cw + DFF + col), w1b = *(const f32x4*)(cw + DFF + col + 4);
                const f32x4 w2a = *(const f32x4*)(cw + 2 * DFF + col), w2b = *(const f32x4*)(cw + 2 * DFF + col + 4), ba = *(const f32x4*)(cb + col), bb = *(const f32x4*)(cb + col + 4);
                f32x4 h2a, h2b, h1a, h1b; unpack8(ra[0], h2a, h2b); unpack8(ra[1], h1a, h1b);
#pragma unroll
                for (int t = 0; t < 8; ++t) {
                    f32x4 ca, cb2, ga, gb; unpack8(ra[t + 2], ca, cb2); unpack8(rb[t], ga, gb);
                    f32x4 va = ba + w0a * h2a + w1a * h1a + w2a * ca, vb2 = bb + w0b * h2b + w1b * h1b + w2b * cb2;
#pragma unroll
                    for (int e = 0; e < 4; ++e) { va[e] = va[e] * pg8::sigmoidf_(va[e]) * ga[e]; vb2[e] = vb2[e] * pg8::sigmoidf_(vb2[e]) * gb[e]; }
                    *(u32x4*)(ACT + (size_t)(t0 + t) * DFF + col) = pack8(va, vb2);
                    h2a = h1a; h2b = h1b; h1a = ca; h1b = cb2;
                }
            }
        } else if (k == 11 && (PHMASK & (1 << 11))) {
            pg8::Gemm g{(const char*)ACT, (const char*)Wt_down, DFF, 2 * DFF, 32, 128};
            pg8::StaticOrder S; S.init(M, 1024, G, bx, (size_t)256 * 2 * DFF, (size_t)256 * DFF * 2);
            if ((RPT & 0x800) && !(it2 & 1)) { pg8::EpiResid E{X, (float*)(ws + WS_OG)}; pg8::gemm_phase<pg8::EpiResid, pg8::StaticOrder, true, true>(L, g, S, E); }
            else if (l == DEPTH - 1) { pg8::EpiResid E{X, args.out + zz}; pg8::gemm_phase<pg8::EpiResid, pg8::StaticOrder, true, true>(L, g, S, E); }
            else { pg8::EpiResidN E{X, X, INF(2) + (l + 1) * 1024, H, SSQ, (LAS float*)(L + XCH_OFF)}; pg8::gemm_phase<pg8::EpiResidN, pg8::StaticOrder, true, true>(L, g, S, E); }
        }
        if (k == 4 || k == 8 || k == 10 || (k == 0 && l > 0)) continue;
        if (it2 + 2 < args.ph_hi * 2 || (RPT != 0 && it2 + 1 < args.ph_hi * 2)) for (int xs = 0; xs <= XSEAM; ++xs) {
#if SEAM_FENCES
            __builtin_amdgcn_fence(__ATOMIC_RELEASE, "agent"); asm volatile("s_waitcnt vmcnt(0) lgkmcnt(0)" ::: "memory");
            grid.sync();
            __builtin_amdgcn_fence(__ATOMIC_ACQUIRE, "agent"); asm volatile("s_waitcnt vmcnt(0) lgkmcnt(0)" ::: "memory");
            __syncthreads();
#elif USE_XBAR
            { XcdBarrier xb_; xb_.bar = (unsigned*)(ws + WS_CTL); xb_.x = xb_xcc_id(); xb_.st = (volatile LAS unsigned*)(L + XBST_OFF); xcd_barrier(xb_); }
#else
            grid.sync();
#endif
        }
    }
#undef INF
}

extern "C" void kernel_launch(void* const* d_in, const int* in_sizes, int n_in, void* d_out, int out_size, void* d_ws, size_t ws_size, hipStream_t stream) {
    static int grid = 0;
    if (grid == 0) {
        if (n_in != 33 || in_sizes[0] != M * DMODEL || out_size != M * DMODEL || ws_size < WS_TOTAL) { fprintf(stderr, "kernel_launch: unexpected shapes/workspace (n_in %d, ws %zu < %zu)\n", n_in, ws_size, (size_t)WS_END); grid = -1; return; }
        int dev = 0, cus = 0, per_cu = 0;
        if (hipGetDevice(&dev) != hipSuccess || hipDeviceGetAttribute(&cus, hipDeviceAttributeMultiprocessorCount, dev) != hipSuccess) { grid = -1; return; }
        if (hipFuncSetAttribute((const void*)fwd, hipFuncAttributeMaxDynamicSharedMemorySize, LDS_BYTES) != hipSuccess) { fprintf(stderr, "kernel_launch: hipFuncSetAttribute failed\n"); grid = -1; return; }
        if (hipOccupancyMaxActiveBlocksPerMultiprocessor(&per_cu, (const void*)fwd, NWAVES * 64, LDS_BYTES) != hipSuccess || per_cu < 1) per_cu = 1;
        (void)hipGetLastError();
        grid = cus;
    }
    if (grid < 0) return;
    if (hipMemsetAsync((char*)d_ws + WS_CTL, 0, CTL_BYTES, stream) != hipSuccess) { fprintf(stderr, "kernel_launch: memset of the barrier words failed\n"); return; }
    Args a{};
    for (int i = 0; i < 33; ++i) a.in[i] = d_in[i];
    a.out = (float*)d_out; a.ws = (unsigned char*)d_ws; a.ph_lo = 0; a.ph_hi = DEPTH * NPH;
    void* kargs[] = {&a};
    hipError_t e = hipLaunchCooperativeKernel((const void*)fwd, dim3(grid), dim3(NWAVES * 64), kargs, LDS_BYTES, stream);
    if (e != hipSuccess) fprintf(stderr, "kernel_launch: cooperative launch failed: %s (grid %d)\n", hipGetErrorString(e), grid);
}
```

```cpp
#include <hip/hip_runtime.h>
#include <hip/hip_cooperative_groups.h>
#include <cstdio>
#include <cstdint>
namespace pg8 {
#define PG8_LAS __attribute__((address_space(3)))
typedef unsigned short bf16_t;
typedef short bf16x8 __attribute__((ext_vector_type(8)));
typedef float f32x4 __attribute__((ext_vector_type(4)));
typedef unsigned u32x4 __attribute__((ext_vector_type(4)));
constexpr int BM = 256, BK = 64, HALF = 128, HTB = HALF * BK * 2  , STAGE_BYTES = 8 * HTB, NXCD = 8, WGM = 8;

__host__ __device__ __forceinline__ int lds_byte(int r, int c) { const int st = (r >> 4) * 2 + (c >> 5), rr = r & 15, cc = c & 31, ob = rr * 64 + cc * 2; return st * 1024 + (ob ^ (((ob >> 9) & 1) << 5)); }
__host__ __device__ __forceinline__ void stage_rc(int b, int& R, int& C) { const int st = b / 1024, sb = b % 1024, swz = sb ^ (((sb >> 9) & 1) << 5); R = (st >> 1) * 16 + swz / 64; C = (st & 1) * 32 + (swz % 64) / 2; }
__host__ __device__ __forceinline__ int perm32(int rho) { const int n = rho >> 4, i = rho & 15; return 8 * (i >> 2) + 4 * n + (i & 3); }


typedef unsigned u32x2 __attribute__((ext_vector_type(2)));
struct Unit { int pm, pn, g; };
struct Gemm { const char* A; const char* Bt; int K; int a_row, a_c16, a_kt; };

struct StaticOrder {
    int nM, nN, nwg, G, c; size_t ta, tb;
    __device__ void init(int M, int N, int G_, int c_, size_t ta_, size_t tb_) { nM = M / BM; nN = N / BM; nwg = nM * nN; G = G_; c = c_; ta = ta_; tb = tb_; }
    __device__ void init_tiles(int nM_, int nN_, int G_, int c_, size_t ta_, size_t tb_) { nM = nM_; nN = nN_; nwg = nM * nN; G = G_; c = c_; ta = ta_; tb = tb_; }
    __device__ bool next(int i, Unit& u) const {
        const long L = (long)i * G + c; if (L >= nwg) return false;
        int wgid = (int)L; { const int q = nwg / NXCD, r = nwg % NXCD, xcd = wgid % NXCD, off = wgid / NXCD; wgid = (xcd < r ? xcd * (q + 1) : r * (q + 1) + (xcd - r) * q) + off; }
        const int nig = WGM * nN, gid = wgid / nig, fm = gid * WGM, gsz = (nM - fm) < WGM ? (nM - fm) : WGM;
        u.pm = fm + ((wgid % nig) % gsz); u.pn = (wgid % nig) / gsz; u.g = 0; return true;
    }
    __device__ __forceinline__ size_t offA(const Unit& u) const { return (size_t)u.pm * ta; }
    __device__ __forceinline__ size_t offB(const Unit& u) const { return (size_t)u.pn * tb; }
};
struct GroupOrder {
    int nM, nN, nwg, G, c; size_t ta, tb, ga, gb;
    __device__ void init(int nM_, int nN_, int G_, int c_, size_t ta_, size_t tb_, size_t ga_, size_t gb_) { nM = nM_; nN = nN_; nwg = 32 * nM_ * nN_; G = G_; c = c_; ta = ta_; tb = tb_; ga = ga_; gb = gb_; }
    __device__ bool next(int i, Unit& u) const {
        const long L = (long)i * G + c; if (L >= nwg) return false;
        const int per = nM * nN, g = (int)L / per, r = (int)L % per; u.g = g; u.pm = r / nN; u.pn = r % nN; return true;
    }
    __device__ __forceinline__ size_t offA(const Unit& u) const { return (size_t)u.g * ga + (size_t)u.pm * ta; }
    __device__ __forceinline__ size_t offB(const Unit& u) const { return (size_t)u.g * gb + (size_t)u.pn * tb; }
};

typedef float f32x2cv __attribute__((ext_vector_type(2))); typedef __bf16 bf16x2cv __attribute__((ext_vector_type(2)));
__device__ __forceinline__ unsigned cvt_pk_bf16(float lo, float hi) { f32x2cv v = {lo, hi}; bf16x2cv b = __builtin_convertvector(v, bf16x2cv); return __builtin_bit_cast(unsigned, b); }
__device__ __forceinline__ float shx(float v, int mask, int lane) { return __int_as_float(__builtin_amdgcn_ds_bpermute((lane ^ mask) << 2, __float_as_int(v))); }
__device__ __forceinline__ float bflo(unsigned w) { return __uint_as_float(w << 16); }
__device__ __forceinline__ float bfhi(unsigned w) { return __uint_as_float(w & 0xffff0000u); }
__device__ __forceinline__ float sigmoidf_(float x) { return __builtin_amdgcn_rcpf(1.0f + __builtin_amdgcn_exp2f(-1.4426950408889634f * x)); }
__device__ __forceinline__ float gelu_tanh(float v) { const float a = 0.7978845608028654f * (v + 0.044715f * v * v * v); const float t = 1.0f - 2.0f * __builtin_amdgcn_rcpf(1.0f + __builtin_amdgcn_exp2f(2.0f * 1.4426950408889634f * a)); return 0.5f * v * (1.0f + t); }
__device__ __forceinline__ u32x4 pack8(const f32x4 a, const f32x4 b) { u32x4 w; w.x = cvt_pk_bf16(a[0], a[1]); w.y = cvt_pk_bf16(a[2], a[3]); w.z = cvt_pk_bf16(b[0], b[1]); w.w = cvt_pk_bf16(b[2], b[3]); return w; }
__device__ __forceinline__ void unpack8(const u32x4 w, f32x4& a, f32x4& b) { a = (f32x4){bflo(w.x), bfhi(w.x), bflo(w.y), bfhi(w.y)}; b = (f32x4){bflo(w.z), bfhi(w.z), bflo(w.w), bfhi(w.w)}; }

#define EPI_ROWS_BEGIN _Pragma("unroll") for (int ai = 0; ai < 2; ++ai) _Pragma("unroll") for (int m = 0; m < 4; ++m) { const int rt = ai * 128 + wr * 64 + m * 16 + fr; const int row = u.pm * 256 + rt; (void)row;
#define EPI_ROWS_END asm volatile("" ::: "memory"); }

__device__ __forceinline__ void row_rstd(float (&rs)[8], const float* ssq, const Unit& u, int wr, int fr) {
    f32x4 q[8];
#pragma unroll
    for (int i = 0; i < 8; ++i) q[i] = *(const f32x4*)(ssq + (size_t)(u.pm * 256 + (i >> 2) * 128 + wr * 64 + (i & 3) * 16 + fr) * 4);
#pragma unroll
    for (int i = 0; i < 8; ++i) rs[i] = __builtin_amdgcn_rsqf(((q[i][0] + q[i][1]) + (q[i][2] + q[i][3])) * (1.0f / 1024.0f) + 1e-6f);
}
struct EpiInProj {
    static constexpr bool PERM = true, HOOK = false, PRE = true;
    bf16_t *qa, *ka, *va, *qb, *kb, *vb, *cu, *gates;
    const float *qn_a, *kn_a, *qn_b, *kn_b, *b_gate, *ropeA, *ropeB;
    PG8_LAS float* xch;
    const float* ssq;
    __device__ __forceinline__ void plain(const f32x4 (&acc)[2][2][4][2], const float (&rsr)[8], const Unit& u, int wr, int wc, int fr, int fq, bf16_t* dst, int ld, int tl) const {
        EPI_ROWS_BEGIN
#pragma unroll
            for (int bj = 0; bj < 2; ++bj) *(u32x4*)(dst + (size_t)row * ld + tl * 256 + bj * 128 + wc * 32 + 8 * fq) = pack8(acc[ai][bj][m][0] * rsr[ai * 4 + m], acc[ai][bj][m][1] * rsr[ai * 4 + m]);
        EPI_ROWS_END
    }
    __device__ __forceinline__ void plain_va(const f32x4 (&acc)[2][2][4][2], const float (&rsr)[8], const Unit& u, int wr, int wc, int fr, int fq, int tl) const {
        EPI_ROWS_BEGIN
#pragma unroll
            for (int bj = 0; bj < 2; ++bj) { const int col = tl * 256 + bj * 128 + wc * 32 + 8 * fq;
                *(u32x4*)(va + ((size_t)(col >> 7) * 16384 + row) * 128 + (col & 127)) = pack8(acc[ai][bj][m][0] * rsr[ai * 4 + m], acc[ai][bj][m][1] * rsr[ai * 4 + m]); }
        EPI_ROWS_END
    }
    __device__ __forceinline__ void plain_cu(const f32x4 (&acc)[2][2][4][2], const float (&rsr)[8], const Unit& u, int wr, int wc, int fr, int fq, int tl) const {
        EPI_ROWS_BEGIN
#pragma unroll
            for (int bj = 0; bj < 2; ++bj) { const int col = tl * 256 + bj * 128 + wc * 32 + 8 * fq;
                *(u32x4*)(cu + ((size_t)(col >> 4) * 16384 + row) * 16 + (col & 15)) = pack8(acc[ai][bj][m][0] * rsr[ai * 4 + m], acc[ai][bj][m][1] * rsr[ai * 4 + m]); }
        EPI_ROWS_END
    }
    __device__ __forceinline__ void gate(const f32x4 (&acc)[2][2][4][2], const float (&rsr)[8], const Unit& u, int wr, int wc, int fr, int fq, int tl) const {
        f32x4 bv[2][2];
#pragma unroll
        for (int bj = 0; bj < 2; ++bj) { const float* bp = b_gate + tl * 256 + bj * 128 + wc * 32 + 8 * fq; bv[bj][0] = *(const f32x4*)bp; bv[bj][1] = *(const f32x4*)(bp + 4); }
        EPI_ROWS_BEGIN
#pragma unroll
            for (int bj = 0; bj < 2; ++bj) { f32x4 a = acc[ai][bj][m][0] * rsr[ai * 4 + m] + bv[bj][0], b = acc[ai][bj][m][1] * rsr[ai * 4 + m] + bv[bj][1];
#pragma unroll
                for (int e = 0; e < 4; ++e) { a[e] = sigmoidf_(a[e]); b[e] = sigmoidf_(b[e]); }
                *(u32x4*)(gates + (size_t)row * 3072 + tl * 256 + bj * 128 + wc * 32 + 8 * fq) = pack8(a, b); }
        EPI_ROWS_END
    }
    __device__ __forceinline__ void norm64(const f32x4 (&acc)[2][2][4][2], const float (&rsr)[8], const Unit& u, int wr, int wc, int fr, int fq, bf16_t* dst, const float* gain, float qs, int tl) const {
        f32x4 g00, g01, g10, g11;
        g00 = (f32x4){gain[2 * fq], gain[2 * fq + 1], gain[8 + 2 * fq], gain[9 + 2 * fq]};
        g01 = *(const f32x4*)(gain + 16 + 4 * fq); g10 = *(const f32x4*)(gain + 32 + 8 * fq); g11 = *(const f32x4*)(gain + 36 + 8 * fq);
        g00 *= qs; g01 *= qs; g10 *= qs; g11 *= qs;
        EPI_ROWS_BEGIN
            const float rw = rsr[ai * 4 + m]; f32x4 v00 = acc[ai][0][m][0] * rw, v01 = acc[ai][0][m][1] * rw, v10 = acc[ai][1][m][0] * rw, v11 = acc[ai][1][m][1] * rw;
            float ss = 0.f;
#pragma unroll
            for (int e = 0; e < 4; ++e) ss += v00[e] * v00[e] + v01[e] * v01[e] + v10[e] * v10[e] + v11[e] * v11[e];
            ss += shx(ss, 16, fq * 16 + fr); ss += shx(ss, 32, fq * 16 + fr);
            const float rs = __builtin_amdgcn_rsqf(ss * (1.0f / 64.0f) + 1e-6f);
            v00 = v00 * rs * g00; v01 = v01 * rs * g01; v10 = v10 * rs * g10; v11 = v11 * rs * g11;
            const f32x4 cs = *(const f32x4*)(ropeA + (size_t)row * 16 + 4 * fq);
            const float o0 = v00[0] * cs[0] - v00[2] * cs[1], o2 = v00[2] * cs[0] + v00[0] * cs[1];
            const float o1 = v00[1] * cs[2] - v00[3] * cs[3], o3 = v00[3] * cs[2] + v00[1] * cs[3];
            bf16_t* base = dst + ((size_t)(tl * 4 + wc) * 16384 + row) * 64;
            *(unsigned*)(base + 2 * fq) = cvt_pk_bf16(o0, o1);
            *(unsigned*)(base + 8 + 2 * fq) = cvt_pk_bf16(o2, o3);
            u32x2 w2; w2.x = cvt_pk_bf16(v01[0], v01[1]); w2.y = cvt_pk_bf16(v01[2], v01[3]);
            *(u32x2*)(base + 16 + 4 * fq) = w2;
            *(u32x4*)(base + 32 + 8 * fq) = pack8(v10, v11);
        EPI_ROWS_END
    }
    __device__ __forceinline__ void norm128(const f32x4 (&acc)[2][2][4][2], const float (&rsr)[8], const Unit& u, int wr, int wc, int fr, int fq, bf16_t* dst, const float* gain, float qs, int tl) const {
        const int w = wc & 1, head = wc >> 1;
        const int d00 = w ? 64 + 8 * fq : 4 * fq, d01 = w ? 68 + 8 * fq : 16 + 4 * fq, d1 = w ? 96 + 8 * fq : 32 + 8 * fq;
        f32x4 g00 = *(const f32x4*)(gain + d00), g01 = *(const f32x4*)(gain + d01), g10 = *(const f32x4*)(gain + d1), g11 = *(const f32x4*)(gain + d1 + 4);
        g00 *= qs; g01 *= qs; g10 *= qs; g11 *= qs;
        float ssr[8];
        EPI_ROWS_BEGIN
            const float rw = rsr[ai * 4 + m]; const f32x4 v00 = acc[ai][0][m][0] * rw, v01 = acc[ai][0][m][1] * rw, v10 = acc[ai][1][m][0] * rw, v11 = acc[ai][1][m][1] * rw;
            float ss = 0.f;
#pragma unroll
            for (int e = 0; e < 4; ++e) ss += v00[e] * v00[e] + v01[e] * v01[e] + v10[e] * v10[e] + v11[e] * v11[e];
            ss += shx(ss, 16, fq * 16 + fr); ss += shx(ss, 32, fq * 16 + fr);
            ssr[ai * 4 + m] = ss;
            if (fq == 0) xch[rt * 4 + wc] = ss;
        EPI_ROWS_END
        asm volatile("s_waitcnt lgkmcnt(0)" ::: "memory"); __builtin_amdgcn_s_barrier(); asm volatile("" ::: "memory");
        EPI_ROWS_BEGIN
            const float rw = rsr[ai * 4 + m]; f32x4 v00 = acc[ai][0][m][0] * rw, v01 = acc[ai][0][m][1] * rw, v10 = acc[ai][1][m][0] * rw, v11 = acc[ai][1][m][1] * rw;
            const float tot = ssr[ai * 4 + m] + xch[rt * 4 + (wc ^ 1)];
            const float rs = __builtin_amdgcn_rsqf(tot * (1.0f / 128.0f) + 1e-6f);
            v00 = v00 * rs * g00; v01 = v01 * rs * g01; v10 = v10 * rs * g10; v11 = v11 * rs * g11;
            if (w == 0) {
                const f32x4 c0 = *(const f32x4*)(ropeB + (size_t)row * 32 + 8 * fq), c1 = *(const f32x4*)(ropeB + (size_t)row * 32 + 8 * fq + 4);
                const float cc[4] = {c0[0], c0[2], c1[0], c1[2]}, sn[4] = {c0[1], c0[3], c1[1], c1[3]};
#pragma unroll
                for (int e = 0; e < 4; ++e) { const float x1 = v00[e], x2 = v01[e]; v00[e] = x1 * cc[e] - x2 * sn[e]; v01[e] = x2 * cc[e] + x1 * sn[e]; }
            }
            bf16_t* base = dst + (size_t)row * 1536 + tl * 256 + head * 128;
            u32x2 a2; a2.x = cvt_pk_bf16(v00[0], v00[1]); a2.y = cvt_pk_bf16(v00[2], v00[3]); *(u32x2*)(base + d00) = a2;
            u32x2 b2; b2.x = cvt_pk_bf16(v01[0], v01[1]); b2.y = cvt_pk_bf16(v01[2], v01[3]); *(u32x2*)(base + d01) = b2;
            *(u32x4*)(base + d1) = pack8(v10, v11);
        EPI_ROWS_END
    }
    __device__ __forceinline__ void prefetch(f32x4 (&q)[8], const Unit& u, int wr, int fr) const {
#pragma unroll
        for (int i = 0; i < 8; ++i) q[i] = *(const f32x4*)(ssq + (size_t)(u.pm * 256 + (i >> 2) * 128 + wr * 64 + (i & 3) * 16 + fr) * 4);
    }
    __device__ __forceinline__ void run(const f32x4 (&acc)[2][2][4][2], const f32x4 (&q)[8], const Unit& u, int wr, int wc, int fr, int fq) const {
        const int pn = u.pn; float rsr[8];
#pragma unroll
        for (int i = 0; i < 8; ++i) rsr[i] = __builtin_amdgcn_rsqf(((q[i][0] + q[i][1]) + (q[i][2] + q[i][3])) * (1.0f / 1024.0f) + 1e-6f);
        if (pn < 2) norm64(acc, rsr, u, wr, wc, fr, fq, qa, qn_a, 0.125f * 1.4426950408889634f, pn);
        else if (pn < 4) norm64(acc, rsr, u, wr, wc, fr, fq, ka, kn_a, 1.0f, pn - 2);
        else if (pn < 6) plain_va(acc, rsr, u, wr, wc, fr, fq, pn - 4);
        else if (pn < 12) norm128(acc, rsr, u, wr, wc, fr, fq, qb, qn_b, 0.08838834764831845f * 1.4426950408889634f, pn - 6);
        else if (pn < 18) norm128(acc, rsr, u, wr, wc, fr, fq, kb, kn_b, 1.0f, pn - 12);
        else if (pn < 24) plain(acc, rsr, u, wr, wc, fr, fq, vb, 1536, pn - 18);
        else if (pn < 26) plain_cu(acc, rsr, u, wr, wc, fr, fq, pn - 24);
        else gate(acc, rsr, u, wr, wc, fr, fq, pn - 26);
    }
};

struct EpiSsm1 {
    static constexpr bool PERM = true, HOOK = false, PRE = false;
    bf16_t* y; float* E;
    __device__ __forceinline__ void operator()(const f32x4 (&acc)[2][2][4][2], const Unit& u, int wr, int wc, int fr, int fq) const {
        const int g = u.g;
        if (u.pn < 2) {
            EPI_ROWS_BEGIN
#pragma unroll
                for (int bj = 0; bj < 2; ++bj) { const int nidx = u.pn * 256 + bj * 128 + wc * 32 + 8 * fq, t = nidx >> 4, c = nidx & 15;
                    *(u32x4*)(y + ((size_t)g * 16384 + (size_t)row * 32 + t) * 16 + c) = pack8(acc[ai][bj][m][0], acc[ai][bj][m][1]); }
            EPI_ROWS_END
        } else {
            EPI_ROWS_BEGIN
                float* p = E + ((size_t)g * 512 + row) * 128 + wc * 32 + 8 * fq; *(f32x4*)p = acc[ai][0][m][0]; *(f32x4*)(p + 4) = acc[ai][0][m][1];
            EPI_ROWS_END
        }
    }
};
struct EpiSsm2 {
    static constexpr bool PERM = true, HOOK = false, PRE = false;
    const bf16_t* y; const bf16_t* cu; const float* dsk; bf16_t* z;
    __device__ __forceinline__ void operator()(const f32x4 (&acc)[2][2][4][2], const Unit& u, int wr, int wc, int fr, int fq) const {
        const int g = u.g;
        EPI_ROWS_BEGIN
#pragma unroll
            for (int bj = 0; bj < 2; ++bj) { const int nidx = u.pn * 256 + bj * 128 + wc * 32 + 8 * fq, t = nidx >> 4, c = nidx & 15;
                const size_t off = ((size_t)row * 32 + t) * 512 + 16 * g + c, offg = ((size_t)g * 16384 + (size_t)row * 32 + t) * 16 + c;
                f32x4 ya, yb; unpack8(*(const u32x4*)(y + offg), ya, yb); f32x4 a = acc[ai][bj][m][0] + ya, b = acc[ai][bj][m][1] + yb;
                f32x4 ua, ub; unpack8(*(const u32x4*)(cu + offg), ua, ub);
                a += ua * *(const f32x4*)(dsk + 16 * g + c); b += ub * *(const f32x4*)(dsk + 16 * g + c + 4);
#pragma unroll
                for (int e = 0; e < 4; ++e) { a[e] = gelu_tanh(a[e]); b[e] = gelu_tanh(b[e]); }
                *(u32x4*)(z + off) = pack8(a, b); asm volatile("" ::: "memory"); }
        EPI_ROWS_END
    }
};
struct EpiGlu {
    static constexpr bool PERM = true, HOOK = false, PRE = false;
    const bf16_t* z; const float* bias; bf16_t* oc; int ldo;
    __device__ __forceinline__ void operator()(const f32x4 (&acc)[2][2][4][2], const Unit& u, int wr, int wc, int fr, int fq) const {
        EPI_ROWS_BEGIN
#pragma unroll
            for (int bj = 0; bj < 2; ++bj) { const int col = u.pn * 256 + bj * 128 + wc * 32 + 8 * fq; const size_t off = (size_t)row * 512 + col;
                f32x4 a = acc[ai][bj][m][0] + *(const f32x4*)(bias + col), b = acc[ai][bj][m][1] + *(const f32x4*)(bias + col + 4);
                f32x4 za, zb; unpack8(*(const u32x4*)(z + off), za, zb);
#pragma unroll
                for (int e = 0; e < 4; ++e) { a[e] = za[e] * sigmoidf_(a[e]); b[e] = zb[e] * sigmoidf_(b[e]); }
                *(u32x4*)(oc + (size_t)row * ldo + col) = pack8(a, b); }
        EPI_ROWS_END
    }
};
template <int IDX> struct EpiMerge {
    static constexpr bool PERM = true, HOOK = false, PRE = false;
    const bf16_t* gates; float* mf; bf16_t* out;
    __device__ __forceinline__ void operator()(const f32x4 (&acc)[2][2][4][2], const Unit& u, int wr, int wc, int fr, int fq) const {
        EPI_ROWS_BEGIN
#pragma unroll
            for (int bj = 0; bj < 2; ++bj) { const int col = u.pn * 256 + bj * 128 + wc * 32 + 8 * fq; const size_t off = (size_t)row * 1024 + col;
                f32x4 ga, gb; unpack8(*(const u32x4*)(gates + (size_t)row * 3072 + IDX * 1024 + col), ga, gb);
                f32x4 a = acc[ai][bj][m][0] * ga, b = acc[ai][bj][m][1] * gb;
                if (IDX > 0) { a += *(const f32x4*)(mf + off); b += *(const f32x4*)(mf + off + 4); }
                if (IDX < 2) { *(f32x4*)(mf + off) = a; *(f32x4*)(mf + off + 4) = b; }
                else *(u32x4*)(out + off) = pack8(a, b); }
        EPI_ROWS_END
    }
};
struct EpiMergeF {
    static constexpr bool PERM = true, HOOK = true, PRE = false;
    const bf16_t* gates; bf16_t* out;
    __device__ __forceinline__ void hook(f32x4 (&acc)[2][2][4][2], const Unit& u, int t, int wr, int wc, int fr, int fq) const {
        const int nx = t >> 3;
        EPI_ROWS_BEGIN
#pragma unroll
            for (int bj = 0; bj < 2; ++bj) { const int col = u.pn * 256 + bj * 128 + wc * 32 + 8 * fq; const bf16_t* gp = gates + (size_t)row * 3072 + (nx - 1) * 1024 + col;
                f32x4 pa, pb, na, nb; unpack8(*(const u32x4*)gp, pa, pb); unpack8(*(const u32x4*)(gp + 1024), na, nb);
#pragma unroll
                for (int e = 0; e < 4; ++e) { acc[ai][bj][m][0][e] *= pa[e] * __builtin_amdgcn_rcpf(na[e]); acc[ai][bj][m][1][e] *= pb[e] * __builtin_amdgcn_rcpf(nb[e]); } }
        EPI_ROWS_END
    }
    __device__ __forceinline__ void operator()(const f32x4 (&acc)[2][2][4][2], const Unit& u, int wr, int wc, int fr, int fq) const {
        EPI_ROWS_BEGIN
#pragma unroll
            for (int bj = 0; bj < 2; ++bj) { const int col = u.pn * 256 + bj * 128 + wc * 32 + 8 * fq;
                f32x4 ga, gb; unpack8(*(const u32x4*)(gates + (size_t)row * 3072 + 2048 + col), ga, gb);
                *(u32x4*)(out + (size_t)row * 1024 + col) = pack8(acc[ai][bj][m][0] * ga, acc[ai][bj][m][1] * gb); }
        EPI_ROWS_END
    }
};
struct EpiResid {
    static constexpr bool PERM = true, HOOK = false, PRE = false;
    const float* xi; float* xo;
    __device__ __forceinline__ void operator()(const f32x4 (&acc)[2][2][4][2], const Unit& u, int wr, int wc, int fr, int fq) const {
        EPI_ROWS_BEGIN
#pragma unroll
            for (int bj = 0; bj < 2; ++bj) { const size_t off = (size_t)row * 1024 + u.pn * 256 + bj * 128 + wc * 32 + 8 * fq;
                *(f32x4*)(xo + off) = *(const f32x4*)(xi + off) + acc[ai][bj][m][0]; *(f32x4*)(xo + off + 4) = *(const f32x4*)(xi + off + 4) + acc[ai][bj][m][1]; }
        EPI_ROWS_END
    }
};
struct EpiResidN {
    static constexpr bool PERM = true, HOOK = false, PRE = false;
    const float* xi; float* xo; const float* gnext; bf16_t* hn; float* ssq; PG8_LAS float* xch;
    __device__ __forceinline__ void operator()(const f32x4 (&acc)[2][2][4][2], const Unit& u, int wr, int wc, int fr, int fq) const {
        f32x4 gv[2][2];
#pragma unroll
        for (int bj = 0; bj < 2; ++bj) { const float* gp = gnext + u.pn * 256 + bj * 128 + wc * 32 + 8 * fq; gv[bj][0] = *(const f32x4*)gp; gv[bj][1] = *(const f32x4*)(gp + 4); }
        EPI_ROWS_BEGIN
            float ss = 0.f;
#pragma unroll
            for (int bj = 0; bj < 2; ++bj) { const size_t off = (size_t)row * 1024 + u.pn * 256 + bj * 128 + wc * 32 + 8 * fq;
                const f32x4 a = *(const f32x4*)(xi + off) + acc[ai][bj][m][0], b = *(const f32x4*)(xi + off + 4) + acc[ai][bj][m][1];
                *(f32x4*)(xo + off) = a; *(f32x4*)(xo + off + 4) = b;
#pragma unroll
                for (int e = 0; e < 4; ++e) ss += a[e] * a[e] + b[e] * b[e];
                *(u32x4*)(hn + off) = pack8(a * gv[bj][0], b * gv[bj][1]); }
            ss += shx(ss, 16, fq * 16 + fr); ss += shx(ss, 32, fq * 16 + fr);
            if (fq == 0) xch[rt * 4 + wc] = ss;
        EPI_ROWS_END
        asm volatile("s_waitcnt lgkmcnt(0)" ::: "memory"); __builtin_amdgcn_s_barrier(); asm volatile("" ::: "memory");
        if (wc == 0 && fq == 0) {
            EPI_ROWS_BEGIN
                const f32x4 q = *(const PG8_LAS f32x4*)(xch + rt * 4);
                ssq[(size_t)row * 4 + u.pn] = (q[0] + q[1]) + (q[2] + q[3]);
            EPI_ROWS_END
        }
    }
};
#define DPP_SHR1(o, s) __int_as_float(__builtin_amdgcn_update_dpp(__float_as_int(o), __float_as_int(s), 0x111, 0xf, 0xf, false))
#define DPP_SHR2(o, s) __int_as_float(__builtin_amdgcn_update_dpp(__float_as_int(o), __float_as_int(s), 0x112, 0xf, 0xf, false))
#define DPP_ROR1(s) __int_as_float(__builtin_amdgcn_update_dpp(0, __float_as_int(s), 0x121, 0xf, 0xf, false))
#define DPP_ROR2(s) __int_as_float(__builtin_amdgcn_update_dpp(0, __float_as_int(s), 0x122, 0xf, 0xf, false))
struct EpiUpConv {
    static constexpr bool PERM = true, HOOK = false, PRE = true;
    bf16_t* act; const float* ssq; const float* cw; const float* cb; PG8_LAS float* xch;
    __device__ __forceinline__ void prefetch(f32x4 (&q)[8], const Unit& u, int wr, int fr) const {
#pragma unroll
        for (int i = 0; i < 8; ++i) { int gr = 254 * u.pm - 2 + (i >> 2) * 128 + wr * 64 + (i & 3) * 16 + fr; gr = gr < 0 ? 0 : (gr > 16383 ? 16383 : gr); q[i] = *(const f32x4*)(ssq + (size_t)gr * 4); }
    }
    __device__ __forceinline__ void run(const f32x4 (&acc)[2][2][4][2], const f32x4 (&q)[8], const Unit& u, int wr, int wc, int fr, int fq) const {
        const int row0 = 254 * u.pm - 2, colw = wc * 32 + 8 * fq, col = u.pn * 128 + colw;
        float rsr[8];
#pragma unroll
        for (int i = 0; i < 8; ++i) rsr[i] = __builtin_amdgcn_rsqf(((q[i][0] + q[i][1]) + (q[i][2] + q[i][3])) * (1.0f / 1024.0f) + 1e-6f);
        const f32x4 w0a = *(const f32x4*)(cw + col), w0b = *(const f32x4*)(cw + col + 4), w1a = *(const f32x4*)(cw + 2816 + col), w1b = *(const f32x4*)(cw + 2816 + col + 4);
        const f32x4 w2a = *(const f32x4*)(cw + 5632 + col), w2b = *(const f32x4*)(cw + 5632 + col + 4), ba = *(const f32x4*)(cb + col), bb = *(const f32x4*)(cb + col + 4);
#pragma unroll
        for (int ai = 0; ai < 2; ++ai) if (fr >= 14) { PG8_LAS float* p = xch + (((ai * 2 + wr) * 2 + (fr - 14)) * 128 + colw);
            *(PG8_LAS f32x4*)p = acc[ai][0][3][0] * rsr[ai * 4 + 3]; *(PG8_LAS f32x4*)(p + 4) = acc[ai][0][3][1] * rsr[ai * 4 + 3]; }
        asm volatile("s_waitcnt lgkmcnt(0)" ::: "memory"); __builtin_amdgcn_s_barrier(); asm volatile("" ::: "memory");
#pragma unroll
        for (int ai = 0; ai < 2; ++ai) {
            f32x4 pv0 = (f32x4){0.f, 0.f, 0.f, 0.f}, pv1 = pv0;
#pragma unroll
            for (int m = 0; m < 4; ++m) {
                const float rs_ = rsr[ai * 4 + m];
                const f32x4 c0 = acc[ai][0][m][0] * rs_, c1 = acc[ai][0][m][1] * rs_;
                f32x4 t1a, t1b, t2a, t2b;
                if (m == 0) {
                    const int s = ai * 2 + wr; t1a = (f32x4){0.f, 0.f, 0.f, 0.f}; t1b = t1a; t2a = t1a; t2b = t1a;
                    if (s > 0 && fr < 2) { const PG8_LAS float* pp = xch + ((s - 1) * 2) * 128 + colw;
                        const f32x4 r62a = *(const PG8_LAS f32x4*)pp, r62b = *(const PG8_LAS f32x4*)(pp + 4), r63a = *(const PG8_LAS f32x4*)(pp + 128), r63b = *(const PG8_LAS f32x4*)(pp + 132);
                        if (fr == 0) { t1a = r63a; t1b = r63b; t2a = r62a; t2b = r62b; } else { t2a = r63a; t2b = r63b; } }
                } else {
#pragma unroll
                    for (int e = 0; e < 4; ++e) { t1a[e] = DPP_ROR1(pv0[e]); t1b[e] = DPP_ROR1(pv1[e]); t2a[e] = DPP_ROR2(pv0[e]); t2b[e] = DPP_ROR2(pv1[e]); }
                }
                f32x4 p1a, p1b, p2a, p2b;
#pragma unroll
                for (int e = 0; e < 4; ++e) { p1a[e] = DPP_SHR1(t1a[e], c0[e]); p1b[e] = DPP_SHR1(t1b[e], c1[e]); p2a[e] = DPP_SHR2(t2a[e], c0[e]); p2b[e] = DPP_SHR2(t2b[e], c1[e]); }
                const int rt = ai * 128 + wr * 64 + m * 16 + fr, gr = row0 + rt, tt = gr & 8191;
                const f32x4 zero4 = (f32x4){0.f, 0.f, 0.f, 0.f};
                if (tt == 0) { p1a = zero4; p1b = zero4; } if (tt <= 1) { p2a = zero4; p2b = zero4; }
                f32x4 va = ba + w0a * p2a + w1a * p1a + w2a * c0, vb = bb + w0b * p2b + w1b * p1b + w2b * c1;
                const f32x4 ga = acc[ai][1][m][0] * rs_, gb = acc[ai][1][m][1] * rs_;
#pragma unroll
                for (int e = 0; e < 4; ++e) { va[e] = va[e] * sigmoidf_(va[e]) * ga[e]; vb[e] = vb[e] * sigmoidf_(vb[e]) * gb[e]; }
                if (rt >= 2 && gr < 16384) *(u32x4*)(act + (size_t)gr * 2816 + col) = pack8(va, vb);
                pv0 = c0; pv1 = c1;
                asm volatile("" ::: "memory");
            }
        }
    }
};
struct EpiUp {
    static constexpr bool PERM = true, HOOK = false, PRE = false;
    bf16_t* fa; bf16_t* fb; const float* ssq;
    __device__ __forceinline__ void operator()(const f32x4 (&acc)[2][2][4][2], const Unit& u, int wr, int wc, int fr, int fq) const {
        float rsr[8]; row_rstd(rsr, ssq, u, wr, fr);
        EPI_ROWS_BEGIN
            const size_t off = (size_t)row * 2816 + u.pn * 128 + wc * 32 + 8 * fq; const float rs_ = rsr[ai * 4 + m];
            *(u32x4*)(fa + off) = pack8(acc[ai][0][m][0] * rs_, acc[ai][0][m][1] * rs_);
            *(u32x4*)(fb + off) = pack8(acc[ai][1][m][0] * rs_, acc[ai][1][m][1] * rs_);
        EPI_ROWS_END
    }
};
template <class Epi, class Sched, bool ALIGN_EPI = false, bool SP2 = false>
__device__ __forceinline__ void gemm_phase(PG8_LAS unsigned char* lds, const Gemm g, const Sched& S, const Epi& E) {
    int tid_ = threadIdx.x; asm volatile("" : "+v"(tid_));
    const int tid = tid_, wid = __builtin_amdgcn_readfirstlane(tid >> 6), lane = tid & 63, wr = wid >> 2, wc = wid & 3, fr = lane & 15, fq = lane >> 4;
    const int K = g.K, nt = K / BK;
    unsigned voffA[2], voffB[2];
#pragma unroll
    for (int i = 0; i < 2; ++i) { int R, C; stage_rc(tid * 16 + i * 8192, R, C); const int Rb = Epi::PERM ? ((R & ~31) + perm32(R & 31)) : R;
        voffA[i] = (unsigned)(R * g.a_row + (C >> 4) * g.a_c16 + (C & 15) * 2); voffB[i] = (unsigned)(Rb * K + C) * 2u; }
    const size_t kstep = (size_t)(BK * 2), kstepA = (size_t)g.a_kt;
    const size_t hstep = (size_t)HALF * K * 2, hstepA = (size_t)HALF * g.a_row;
    const unsigned ldsw = (unsigned)wid * 1024u;
    const int aoff = lds_byte(wr * 64 + fr, fq * 8), boff = lds_byte(wc * 32 + fr, fq * 8);
#define PG8_SA(b, h) (((b) * 2 + (h)) * HTB)
#define PG8_SB(b, h) ((4 + (b) * 2 + (h)) * HTB)
#define PG8_STAGE(bufoff, gbase, voff) do { _Pragma("unroll") for (int _i = 0; _i < 2; ++_i) \
        __builtin_amdgcn_global_load_lds((const unsigned*)((const char*)(gbase) + (voff)[_i]), (PG8_LAS unsigned*)(lds + (bufoff) + ldsw + _i * 8192), 16, 0, 0); } while (0)
#define PG8_LDA(dst, b, h) do { _Pragma("unroll") for (int m = 0; m < 4; ++m) _Pragma("unroll") for (int k = 0; k < 2; ++k) dst[m][k] = *(const PG8_LAS bf16x8*)(lds + PG8_SA(b, h) + aoff + m * 2048 + k * 1024); } while (0)
#define PG8_LDB(dst, b, h) do { _Pragma("unroll") for (int n = 0; n < 2; ++n) _Pragma("unroll") for (int k = 0; k < 2; ++k) dst[n][k] = *(const PG8_LAS bf16x8*)(lds + PG8_SB(b, h) + boff + n * 2048 + k * 1024); } while (0)
#define PG8_MMA(ai, bj, At, Bt) do { __builtin_amdgcn_s_setprio(1); _Pragma("unroll") for (int m = 0; m < 4; ++m) _Pragma("unroll") for (int n = 0; n < 2; ++n) _Pragma("unroll") for (int k = 0; k < 2; ++k) \
        acc[ai][bj][m][n] = __builtin_amdgcn_mfma_f32_16x16x32_bf16(Bt[n][k], At[m][k], acc[ai][bj][m][n], 0, 0, 0); __builtin_amdgcn_s_setprio(0); } while (0)
#define PG8_WAIT_V(n) asm volatile("s_waitcnt vmcnt(" #n ")" ::: "memory")
#define PG8_WAIT_L(n) asm volatile("s_waitcnt lgkmcnt(" #n ")" ::: "memory")
#define PG8_BAR __builtin_amdgcn_s_barrier()
#define PG8_SCHED __builtin_amdgcn_sched_barrier(0)
    Unit cur, nxt; int ui = 0;
    if (!S.next(0, cur)) return;
    f32x4 acc[2][2][4][2];
#pragma unroll
    for (int a = 0; a < 2; ++a)
#pragma unroll
        for (int b = 0; b < 2; ++b)
#pragma unroll
            for (int m = 0; m < 4; ++m)
#pragma unroll
                for (int n = 0; n < 2; ++n) acc[a][b][m][n] = (f32x4){0.f, 0.f, 0.f, 0.f};
    bf16x8 At[4][2], B0[2][2], B1[2][2];
    const char* cA = (const char*)g.A + S.offA(cur); const char* cB = (const char*)g.Bt + S.offB(cur);
    if constexpr (SP2) {
        PG8_STAGE(PG8_SB(0, 0), cB, voffB); PG8_STAGE(PG8_SB(0, 1), cB + hstep, voffB); PG8_STAGE(PG8_SA(0, 0), cA, voffA); PG8_STAGE(PG8_SA(0, 1), cA + hstepA, voffA);
        if (wr == 1) PG8_BAR;
        PG8_WAIT_V(2); PG8_BAR;
        PG8_STAGE(PG8_SB(1, 0), cB + kstep, voffB); PG8_STAGE(PG8_SA(1, 0), cA + kstepA, voffA); PG8_STAGE(PG8_SB(1, 1), cB + hstep + kstep, voffB);
        PG8_WAIT_V(6); PG8_BAR;
    } else {
        PG8_STAGE(PG8_SB(0, 0), cB, voffB); PG8_STAGE(PG8_SA(0, 0), cA, voffA); PG8_STAGE(PG8_SB(0, 1), cB + hstep, voffB); PG8_STAGE(PG8_SA(0, 1), cA + hstepA, voffA);
        if (wr == 1) PG8_BAR;
        PG8_WAIT_V(4); PG8_BAR;
        PG8_STAGE(PG8_SB(1, 0), cB + kstep, voffB); PG8_STAGE(PG8_SA(1, 0), cA + kstepA, voffA); PG8_STAGE(PG8_SB(1, 1), cB + hstep + kstep, voffB);
        PG8_WAIT_V(6); PG8_BAR;
    }
    for (;;) {
        const bool has_next = S.next(ui + 1, nxt);
        const char* nA = has_next ? (const char*)g.A + S.offA(nxt) : cA; const char* nB = has_next ? (const char*)g.Bt + S.offB(nxt) : cB;
        for (int t = 0; t < nt; t += 2) {
            if constexpr (Epi::HOOK) { if (t == 8 || t == 16) { int fr_ = fr, fq_ = fq; asm volatile("" : "+v"(fr_), "+v"(fq_)); E.hook(acc, cur, t, wr, wc, fr_, fq_); } }
            const bool last = (t == nt - 2);
            const char* a1 = cA + (size_t)(t + 1) * kstepA;
            const char* a2 = last ? nA : cA + (size_t)(t + 2) * kstepA; const char* b2 = last ? nB : cB + (size_t)(t + 2) * kstep;
            const char* a3 = a2 + kstepA; const char* b3 = b2 + kstep;
            if constexpr (SP2) {
            PG8_LDB(B0, 0, 0); PG8_LDB(B1, 0, 1); PG8_SCHED; PG8_LDA(At, 0, 0); PG8_STAGE(PG8_SA(1, 1), a1 + hstepA, voffA);
            PG8_WAIT_V(8); PG8_WAIT_L(0); PG8_BAR; PG8_MMA(0, 0, At, B0); PG8_MMA(0, 1, At, B1); PG8_BAR; PG8_SCHED;
            PG8_LDA(At, 0, 1); PG8_STAGE(PG8_SB(0, 0), b2, voffB); PG8_STAGE(PG8_SB(0, 1), b2 + hstep, voffB); PG8_STAGE(PG8_SA(0, 0), a2, voffA);
            PG8_WAIT_V(8); PG8_WAIT_L(0); PG8_BAR; PG8_MMA(1, 0, At, B0); PG8_MMA(1, 1, At, B1); PG8_BAR; PG8_SCHED;
            PG8_LDB(B0, 1, 0); PG8_LDB(B1, 1, 1); PG8_SCHED; PG8_LDA(At, 1, 0); PG8_STAGE(PG8_SA(0, 1), a2 + hstepA, voffA);
            PG8_WAIT_V(8); PG8_WAIT_L(0); PG8_BAR; PG8_MMA(0, 0, At, B0); PG8_MMA(0, 1, At, B1); PG8_BAR; PG8_SCHED;
            PG8_LDA(At, 1, 1); PG8_STAGE(PG8_SB(1, 0), b3, voffB); PG8_STAGE(PG8_SB(1, 1), b3 + hstep, voffB); PG8_STAGE(PG8_SA(1, 0), a3, voffA);
            PG8_WAIT_V(8); PG8_WAIT_L(0); PG8_BAR; PG8_MMA(1, 0, At, B0); PG8_MMA(1, 1, At, B1); PG8_BAR; PG8_SCHED;
            } else {
            PG8_LDB(B0, 0, 0); PG8_SCHED; PG8_LDA(At, 0, 0); PG8_STAGE(PG8_SA(1, 1), a1 + hstepA, voffA);
            PG8_WAIT_L(8); PG8_BAR; PG8_WAIT_L(0); PG8_MMA(0, 0, At, B0); PG8_BAR; PG8_SCHED;
            PG8_LDB(B1, 0, 1); PG8_STAGE(PG8_SB(0, 0), b2, voffB);
            PG8_BAR; PG8_WAIT_L(0); PG8_MMA(0, 1, At, B1); PG8_BAR;
            PG8_LDA(At, 0, 1); PG8_STAGE(PG8_SA(0, 0), a2, voffA);
            PG8_BAR; PG8_WAIT_L(0); PG8_MMA(1, 0, At, B0); PG8_BAR; PG8_SCHED;
            PG8_STAGE(PG8_SB(0, 1), b2 + hstep, voffB);
            PG8_WAIT_V(6); PG8_BAR; PG8_MMA(1, 1, At, B1); PG8_BAR;
            PG8_LDB(B0, 1, 0); PG8_SCHED; PG8_LDA(At, 1, 0); PG8_STAGE(PG8_SA(0, 1), a2 + hstepA, voffA);
            PG8_WAIT_L(8); PG8_BAR; PG8_WAIT_L(0); PG8_MMA(0, 0, At, B0); PG8_BAR; PG8_SCHED;
            PG8_LDB(B1, 1, 1); PG8_STAGE(PG8_SB(1, 0), b3, voffB);
            PG8_BAR; PG8_WAIT_L(0); PG8_MMA(0, 1, At, B1); PG8_BAR;
            PG8_LDA(At, 1, 1); PG8_STAGE(PG8_SA(1, 0), a3, voffA);
            PG8_BAR; PG8_WAIT_L(0); PG8_MMA(1, 0, At, B0); PG8_BAR; PG8_SCHED;
            PG8_STAGE(PG8_SB(1, 1), b3 + hstep, voffB);
            PG8_WAIT_V(6); PG8_BAR; PG8_MMA(1, 1, At, B1); PG8_BAR;
            }
        }
        f32x4 preq[8]; if constexpr (Epi::PRE) { int fr_ = fr; asm volatile("" : "+v"(fr_)); E.prefetch(preq, cur, wr, fr_); }
        if constexpr (ALIGN_EPI) { if (wr == 0) PG8_BAR; }
        { int fr_ = fr, fq_ = fq; asm volatile("" : "+v"(fr_), "+v"(fq_)); if constexpr (Epi::PRE) E.run(acc, preq, cur, wr, wc, fr_, fq_); else E(acc, cur, wr, wc, fr_, fq_); }
        if (!has_next) break;
#pragma unroll
        for (int a = 0; a < 2; ++a)
#pragma unroll
            for (int b = 0; b < 2; ++b)
#pragma unroll
                for (int m = 0; m < 4; ++m)
#pragma unroll
                    for (int n = 0; n < 2; ++n) acc[a][b][m][n] = (f32x4){0.f, 0.f, 0.f, 0.f};
        cur = nxt; cA = nA; cB = nB; ++ui;
        if constexpr (ALIGN_EPI) { if (wr == 1) PG8_BAR; }
    }
    PG8_WAIT_V(0);
    if constexpr (!ALIGN_EPI) { if (wr == 0) PG8_BAR; }
    PG8_BAR;
#undef PG8_SA
#undef PG8_SB
#undef PG8_STAGE
#undef PG8_LDA
#undef PG8_LDB
#undef PG8_MMA
#undef PG8_WAIT_V
#undef PG8_WAIT_L
#undef PG8_BAR
#undef PG8_SCHED
}
}

#include <hip/hip_bf16.h>
#include <cmath>
namespace attn_body {
using bf16=__hip_bfloat16;
using bf16x8=__attribute__((ext_vector_type(8)))short;
using s16x4=__attribute__((ext_vector_type(4)))short;
using f32x16=__attribute__((ext_vector_type(16)))float;
using u32x4=__attribute__((ext_vector_type(4)))unsigned;
constexpr int BATCH=2,NHEAD=16,SEQ=8192,D=64,DM=NHEAD*D, QP=64,KP=64,VP=128,OP=1024;
constexpr int NW=8,QBLK=32,QB=QBLK*NW,KVBLK=64,NQB=SEQ/QB;
constexpr int ATTN_PITCH=DM, ATTN_UNIT_ROWS=QB;
__device__ __forceinline__ int crow(int r,int hi){return (r&3)+8*(r>>2)+4*hi;}
#define SBAR() __builtin_amdgcn_sched_barrier(0)
__device__ __forceinline__ void cmask(f32x16&p0,f32x16&p1,int jb,int qrel,int hi){
  const float NEG=-INFINITY; int kb=64*jb+4*hi;
  #pragma unroll
  for(int r=0;r<16;++r){int kv=kb+(r&3)+8*(r>>2); if(kv>qrel)p0[r]=NEG; if(kv+32>qrel)p1[r]=NEG;}
}

constexpr int NSLOT=3, SLOTB=8192;
constexpr int LDS_K=0, LDS_V=NSLOT*SLOTB, LDS_WS=2*NSLOT*SLOTB, LDS_OST=LDS_WS+NW*64*4, LDS_BYTES=LDS_OST+NW*4096;
constexpr float C2=0.125f*1.4426950408889634f;
__device__ __forceinline__ void glds16(const void*gsrc,unsigned lds_dst){unsigned keep;
  asm volatile("s_mov_b32 %0, m0\n\ts_mov_b32 m0, %2\n\ts_nop 0\n\tglobal_load_lds_dwordx4 %1, off\n\ts_mov_b32 m0, %0":"=&s"(keep):"v"(gsrc),"s"(lds_dst):"memory");}
__device__ __forceinline__ float max3f(float a,float b,float c){float r;asm("v_max3_f32 %0, %1, %2, %3":"=v"(r):"v"(a),"v"(b),"v"(c));return r;}
__device__ __forceinline__ float max2f(float a,float b){float r;asm("v_max_f32_e32 %0, %1, %2":"=v"(r):"v"(a),"v"(b));return r;}
__device__ __forceinline__ float fadd_s(float a,float b){float r;asm("v_add_f32_e32 %0, %1, %2":"=v"(r):"v"(a),"v"(b));return r;}
__device__ __forceinline__ float fsub_s(float a,float b){float r;asm("v_sub_f32_e32 %0, %1, %2":"=v"(r):"v"(a),"v"(b));return r;}
typedef float f32x2_t __attribute__((ext_vector_type(2))); typedef __bf16 bf16x2_t __attribute__((ext_vector_type(2)));
__device__ __forceinline__ unsigned cvtpk_s(float lo,float hi){f32x2_t v={lo,hi};bf16x2_t b=__builtin_convertvector(v,bf16x2_t);return __builtin_bit_cast(unsigned,b);}
#define WAIT_BAR(N) asm volatile("s_waitcnt vmcnt(" #N ") lgkmcnt(0)\n\ts_barrier":::"memory")

__device__ __forceinline__ void qkt(f32x16&p0,f32x16&p1,const char*Kslot,const bf16x8*qr,const f32x16&negm,int r32,int hi){
  const char*kb=Kslot+hi*1024+r32*16;
  #pragma unroll
  for(int d0=0;d0<4;++d0){
    const bf16x8 b0=*reinterpret_cast<const bf16x8*>(kb+d0*2048);
    const bf16x8 b1=*reinterpret_cast<const bf16x8*>(kb+d0*2048+512);
    if(d0==0){p0=__builtin_amdgcn_mfma_f32_32x32x16_bf16(b0,qr[0],negm,0,0,0);p1=__builtin_amdgcn_mfma_f32_32x32x16_bf16(b1,qr[0],negm,0,0,0);}
    else{p0=__builtin_amdgcn_mfma_f32_32x32x16_bf16(b0,qr[d0],p0,0,0,0);p1=__builtin_amdgcn_mfma_f32_32x32x16_bf16(b1,qr[d0],p1,0,0,0);}}
}
typedef __attribute__((address_space(3))) const char* lds_cptr;
typedef short v4i16_t __attribute__((ext_vector_type(4)));
__device__ __forceinline__ void kload8(bf16x8*kf,lds_cptr kp){
  kf[0]=*(const __attribute__((address_space(3))) bf16x8*)(kp);      kf[1]=*(const __attribute__((address_space(3))) bf16x8*)(kp+512);
  kf[2]=*(const __attribute__((address_space(3))) bf16x8*)(kp+2048); kf[3]=*(const __attribute__((address_space(3))) bf16x8*)(kp+2560);
  kf[4]=*(const __attribute__((address_space(3))) bf16x8*)(kp+4096); kf[5]=*(const __attribute__((address_space(3))) bf16x8*)(kp+4608);
  kf[6]=*(const __attribute__((address_space(3))) bf16x8*)(kp+6144); kf[7]=*(const __attribute__((address_space(3))) bf16x8*)(kp+6656);
}
__device__ __forceinline__ void kload2(bf16x8*kf,lds_cptr kp,int j){ kf[2*j]=*(const __attribute__((address_space(3))) bf16x8*)(kp+j*2048); kf[2*j+1]=*(const __attribute__((address_space(3))) bf16x8*)(kp+j*2048+512); }
__device__ __forceinline__ s16x4 vtr(lds_cptr p){ return __builtin_bit_cast(s16x4,__builtin_amdgcn_ds_read_tr16_b64_v4i16((__attribute__((address_space(3))) v4i16_t*)p)); }
__device__ __forceinline__ float rowmax(const f32x16&p0,const f32x16&p1){
  float a=max3f(p0[0],p0[1],p1[0]),b=max3f(p0[2],p0[3],p1[1]);a=max3f(a,p1[2],p1[3]);
  #pragma unroll
  for(int r=4;r<16;r+=4){a=max3f(a,p0[r],p0[r+1]);b=max3f(b,p0[r+2],p0[r+3]);a=max3f(a,p1[r],p1[r+1]);b=max3f(b,p1[r+2],p1[r+3]);}
  const float m=max2f(a,b);
  auto rr=__builtin_amdgcn_permlane32_swap(__float_as_uint(m),__float_as_uint(m),false,false);
  return max2f(__uint_as_float(rr[0]),__uint_as_float(rr[1]));
}
__device__ __forceinline__ void pv(f32x16*o,int vb,bf16x8 pa0,bf16x8 pa1,bf16x8 pa2,bf16x8 pa3){
  #pragma unroll
  for(int d0=0;d0<2;++d0){s16x4 lo[4],hi[4];
    #pragma unroll
    for(int ks=0;ks<4;++ks){
      asm volatile("ds_read_b64_tr_b16 %0,%1 offset:%c2":"=&v"(lo[ks]):"v"(vb),"i"(d0*4096+ks*1024):"memory");
      asm volatile("ds_read_b64_tr_b16 %0,%1 offset:%c2":"=&v"(hi[ks]):"v"(vb),"i"(d0*4096+ks*1024+512):"memory");}
    asm volatile("s_waitcnt lgkmcnt(0)":::"memory");SBAR();
    #define PK(k) (bf16x8){lo[k][0],lo[k][1],lo[k][2],lo[k][3],hi[k][0],hi[k][1],hi[k][2],hi[k][3]}
    o[d0]=__builtin_amdgcn_mfma_f32_32x32x16_bf16(pa0,PK(0),o[d0],0,0,0);
    o[d0]=__builtin_amdgcn_mfma_f32_32x32x16_bf16(pa1,PK(1),o[d0],0,0,0);
    o[d0]=__builtin_amdgcn_mfma_f32_32x32x16_bf16(pa2,PK(2),o[d0],0,0,0);
    o[d0]=__builtin_amdgcn_mfma_f32_32x32x16_bf16(pa3,PK(3),o[d0],0,0,0);
    #undef PK
  }
}

#ifndef ATTN_STORE16
#define ATTN_STORE16(p,v) (*(u32x4*)(p)=(v))
#endif
template<int THRL> __device__ __forceinline__ void attn_unit(int b,int h,int qb,const bf16*Q,const bf16*__restrict__ K,const bf16*__restrict__ V,bf16*O,char*shm){
  int tid_=threadIdx.x; asm volatile("":"+v"(tid_)); const int tid=tid_,lane=tid&63,r32=lane&31,hi=lane>>5; const int wid=__builtin_amdgcn_readfirstlane(tid>>6);
  const long rowbase=(long)b*SEQ; const int q0=qb*QB;
  const bf16*Qw=Q+((long)(h>>1)*(BATCH*SEQ)+rowbase+q0+wid*QBLK)*QP;
  const bf16*Kh=K+((long)(h>>1)*(BATCH*SEQ)+rowbase)*KP,*Vh=V+((long)(h>>2)*(BATCH*SEQ)+rowbase)*VP+(h&1)*64;
  const unsigned lds0=(unsigned)(uintptr_t)shm;
  float*wsf=(float*)(shm+LDS_WS)+wid*64;
  const bf16*ksrc=Kh+(long)lane*KP+wid*8;
  const bf16*vsrc=Vh+(long)(16*(wid&3)+(lane>>2))*VP+(wid>>2)*32+(lane&3)*8;
  const unsigned kdst=lds0+LDS_K+wid*1024, vdst=lds0+LDS_V+wid*1024;
  #define DMA_K(t,slot) glds16(ksrc+(long)(t)*KVBLK*KP,(unsigned)__builtin_amdgcn_readfirstlane(kdst+(slot)))
  #define DMA_V(t,slot) glds16(vsrc+(long)(t)*KVBLK*VP,(unsigned)__builtin_amdgcn_readfirstlane(vdst+(slot)))
  const int vb0=(int)(lds0+LDS_V)+((lane>>4)&1)*32+(lane&3)*8+(4*hi+((lane&15)>>2))*64;
  const char*Kbase=shm+LDS_K; bf16x8 kf[8];
  const lds_cptr shm3=(lds_cptr)shm; const lds_cptr kp0=shm3+LDS_K+hi*1024+r32*16; const lds_cptr vp0=shm3+LDS_V+((lane>>4)&1)*32+(lane&3)*8+(4*hi+((lane&15)>>2))*64;
  const int NT=(q0+QB)/KVBLK;
  DMA_K(0,0);DMA_V(0,0);DMA_K(1,SLOTB);
  bf16x8 qr[4];
  #pragma unroll
  for(int d0=0;d0<4;++d0)qr[d0]=*reinterpret_cast<const bf16x8*>(&Qw[(long)r32*QP+d0*16+hi*8]);
  float mhat=0.f,l_reg=0.f;f32x16 o[2];o[0]=f32x16{};o[1]=f32x16{};f32x16 negm=f32x16{};asm volatile("":"+v"(negm));
  const int qrel=wid*QBLK+r32;
  #define CMASK(P0,P1,t) do{int jb_=(t)-(NT-4); if(jb_>=0)cmask(P0,P1,jb_,qrel,hi);}while(0)
  bool resc=false;
  #define START(P0,P1) do{ const float rm=rowmax(P0,P1); resc=false; \
    { const float dl=rm; mhat=fadd_s(mhat,dl); \
      _Pragma("unroll") for(int r=0;r<16;++r){P0[r]=fsub_s(P0[r],dl);P1[r]=fsub_s(P1[r],dl);} \
      _Pragma("unroll") for(int r=0;r<16;++r)negm[r]=-mhat; asm volatile("":"+v"(negm)); } \
    _Pragma("unroll") for(int r=0;r<16;++r)P0[r]=__builtin_amdgcn_exp2f(P0[r]); }while(0)
  #define RESC() do{ if(resc){ asm volatile("s_waitcnt lgkmcnt(0)":::"memory"); \
      _Pragma("unroll") for(int d_=0;d_<2;++d_) _Pragma("unroll") for(int r=0;r<16;++r)o[d_][r]*=wsf[crow(r,hi)]; } }while(0)
  f32x16 pA0,pA1,pB0,pB1;
  int sl_prev=0,sl_cur=0,sl_next=SLOTB;
  #define ROT() do{sl_prev=sl_cur;sl_cur=sl_next;sl_next=(sl_next==(NSLOT-1)*SLOTB)?0:sl_next+SLOTB;}while(0)
  DMA_K(2,2*SLOTB);
  WAIT_BAR(3);
  qkt(pA0,pA1,Kbase,qr,negm,r32,hi);asm volatile("s_nop 15\n\ts_nop 7":"+v"(pA0),"+v"(pA1));CMASK(pA0,pA1,0);
  START(pA0,pA1);
  _Pragma("unroll") for(int r=0;r<16;++r)pA1[r]=__builtin_amdgcn_exp2f(pA1[r]);
  WAIT_BAR(0);
  DMA_K(3,0);DMA_V(1,SLOTB);
  ROT();
  kload8(kf,kp0+sl_cur);
  WAIT_BAR(2);
  s16x4 vlo[8],vhi[8]; u32x4 pw0,pw1,pw2,pw3;
  #define PKW(P,B) cvtpk_s(P[B],P[B+1])
  #define PAF(k) __builtin_bit_cast(bf16x8,pw##k)
  #define VFR(i) (bf16x8){vlo[i][0],vlo[i][1],vlo[i][2],vlo[i][3],vhi[i][0],vhi[i][1],vhi[i][2],vhi[i][3]}
  #define PIN(x) asm volatile("":"+v"(x))
  #define MX3(a,b,c) __builtin_fmaxf(__builtin_fmaxf((a),(b)),(c))
  #define GAPA(MF,A0,A1,A2,A3,W0,W1,PW) do{ MF; sacc+=A0; sacc+=A1; sacc+=A2; sacc+=A3; PIN(sacc); W0; W1; PIN(PW); SBAR(); }while(0)
  #define EX(v) __builtin_amdgcn_exp2f(v)
  #define GAPB(MF,X,B) do{ MF; X[B]=EX(X[B]); X[B+1]=EX(X[B+1]); X[B+2]=EX(X[B+2]); X[B+3]=EX(X[B+3]); PIN(X); SBAR(); }while(0)
  #define VRD(i) do{ vlo[i]=vtr(vp_+(((i)>>2)*4096+((i)&3)*1024)); vhi[i]=vtr(vp_+(((i)>>2)*4096+((i)&3)*1024+512)); }while(0)
  #define KRD(G,j) do{ if(G){ kload2(kf,kp0+sl_next,j); SBAR(); } }while(0)
  #define STEP(C0,C1,P0,P1,t,GK,GV,GL) do{ SBAR(); \
    const lds_cptr vp_=vp0+sl_prev; \
    VRD(0); SBAR(); float sacc=(P0[0]+P0[1]); \
    GAPA(C0=__builtin_amdgcn_mfma_f32_32x32x16_bf16(kf[0],qr[0],negm,0,0,0), P0[2],P0[3],P0[4],P0[5],     pw0[0]=PKW(P0,0), pw0[1]=PKW(P0,2), pw0); \
    VRD(4); SBAR(); GAPA(C1=__builtin_amdgcn_mfma_f32_32x32x16_bf16(kf[1],qr[0],negm,0,0,0), P0[6],P0[7],P0[8],P0[9],     pw0[2]=PKW(P0,4), pw0[3]=PKW(P0,6), pw0); \
    VRD(1); SBAR(); GAPA(C0=__builtin_amdgcn_mfma_f32_32x32x16_bf16(kf[2],qr[1],C0,0,0,0),   P0[10],P0[11],P0[12],P0[13], pw1[0]=PKW(P0,8), pw1[1]=PKW(P0,10), pw1); \
    VRD(5); SBAR(); GAPA(C1=__builtin_amdgcn_mfma_f32_32x32x16_bf16(kf[3],qr[1],C1,0,0,0),   P0[14],P0[15],P1[0],P1[1],   pw1[2]=PKW(P0,12),pw1[3]=PKW(P0,14), pw1); \
    VRD(2); SBAR(); GAPA(C0=__builtin_amdgcn_mfma_f32_32x32x16_bf16(kf[4],qr[2],C0,0,0,0),   P1[2],P1[3],P1[4],P1[5],     pw2[0]=PKW(P1,0), pw2[1]=PKW(P1,2), pw2); \
    VRD(6); SBAR(); GAPA(C1=__builtin_amdgcn_mfma_f32_32x32x16_bf16(kf[5],qr[2],C1,0,0,0),   P1[6],P1[7],P1[8],P1[9],     pw2[2]=PKW(P1,4), pw2[3]=PKW(P1,6), pw2); \
    VRD(3); SBAR(); GAPA(C0=__builtin_amdgcn_mfma_f32_32x32x16_bf16(kf[6],qr[3],C0,0,0,0),   P1[10],P1[11],P1[12],P1[13], pw3[0]=PKW(P1,8), pw3[1]=PKW(P1,10), pw3); \
    VRD(7); SBAR(); GAPA(C1=__builtin_amdgcn_mfma_f32_32x32x16_bf16(kf[7],qr[3],C1,0,0,0),   P1[14],P1[15],0.f,0.f,       pw3[2]=PKW(P1,12),pw3[3]=PKW(P1,14), pw3); \
    l_reg+=sacc; \
    if(GK){DMA_K((t)+3,sl_cur);} if(GV){DMA_V((t)+1,sl_next);} \
    CMASK(C0,C1,t); \
    { float a=MX3(C0[0],C0[1],C1[0]),b=MX3(C0[2],C0[3],C1[1]); a=MX3(a,C1[2],C1[3]); \
      _Pragma("unroll") for(int r=4;r<16;r+=4){a=MX3(a,C0[r],C0[r+1]);b=MX3(b,C0[r+2],C0[r+3]);a=MX3(a,C1[r],C1[r+1]);b=MX3(b,C1[r+2],C1[r+3]);} \
      float rm=__builtin_fmaxf(a,b); { auto rr=__builtin_amdgcn_permlane32_swap(__float_as_uint(rm),__float_as_uint(rm),false,false); rm=__builtin_fmaxf(__uint_as_float(rr[0]),__uint_as_float(rr[1])); } \
      resc=false; \
      if(__builtin_expect(__any(rm>(float)THRL),0)){ const float dl=__builtin_fmaxf(rm,0.f); mhat+=dl; \
        _Pragma("unroll") for(int r=0;r<16;++r){C0[r]-=dl;C1[r]-=dl;} \
        _Pragma("unroll") for(int r=0;r<16;++r)negm[r]=-mhat; asm volatile("":"+v"(negm)); \
        const float f=__builtin_amdgcn_exp2f(-dl); l_reg*=f; if(hi==0)wsf[r32]=f; resc=true; } } \
    SBAR(); \
    GAPB(o[0]=__builtin_amdgcn_mfma_f32_32x32x16_bf16(PAF(0),VFR(0),o[0],0,0,0), C0,0); \
    GAPB(o[1]=__builtin_amdgcn_mfma_f32_32x32x16_bf16(PAF(0),VFR(4),o[1],0,0,0), C0,4); \
    KRD(GL,0); GAPB(o[0]=__builtin_amdgcn_mfma_f32_32x32x16_bf16(PAF(1),VFR(1),o[0],0,0,0), C0,8); \
    KRD(GL,1); GAPB(o[1]=__builtin_amdgcn_mfma_f32_32x32x16_bf16(PAF(1),VFR(5),o[1],0,0,0), C0,12); \
    KRD(GL,2); GAPB(o[0]=__builtin_amdgcn_mfma_f32_32x32x16_bf16(PAF(2),VFR(2),o[0],0,0,0), C1,0); \
    KRD(GL,3); GAPB(o[1]=__builtin_amdgcn_mfma_f32_32x32x16_bf16(PAF(2),VFR(6),o[1],0,0,0), C1,4); \
    GAPB(o[0]=__builtin_amdgcn_mfma_f32_32x32x16_bf16(PAF(3),VFR(3),o[0],0,0,0), C1,8); \
    GAPB(o[1]=__builtin_amdgcn_mfma_f32_32x32x16_bf16(PAF(3),VFR(7),o[1],0,0,0), C1,12); \
    }while(0)
  int t=1;
  #undef CMASK
  #define CMASK(P0,P1,t) do{}while(0)
  for(;t+5<NT;t+=2){
    STEP(pB0,pB1,pA0,pA1,t,true,true,true);     WAIT_BAR(2); RESC(); ROT();
    STEP(pA0,pA1,pB0,pB1,t+1,true,true,true);   WAIT_BAR(2); RESC(); ROT();
  }
  #undef CMASK
  #define CMASK(P0,P1,t) do{int jb_=(t)-(NT-4); if(jb_>=0)cmask(P0,P1,jb_,qrel,hi);}while(0)
  #define ENDW(tt) do{ if((tt)+3<NT){WAIT_BAR(2);} else if((tt)+2<NT){WAIT_BAR(1);} else {WAIT_BAR(0);} }while(0)
  for(;t+1<NT;t+=2){
    STEP(pB0,pB1,pA0,pA1,t,(t+3<NT),(t+1<NT),(t+1<NT));       ENDW(t);   RESC(); ROT();
    STEP(pA0,pA1,pB0,pB1,t+1,(t+4<NT),(t+2<NT),(t+2<NT));     ENDW(t+1); RESC(); ROT();
  }
  STEP(pB0,pB1,pA0,pA1,NT-1,false,false,false); RESC();
  { float sacc=pB0[0]+pB0[1]; _Pragma("unroll") for(int r=2;r<16;++r)sacc+=pB0[r]; _Pragma("unroll") for(int r=0;r<16;++r)sacc+=pB1[r]; l_reg+=sacc;
    pw0=(u32x4){PKW(pB0,0),PKW(pB0,2),PKW(pB0,4),PKW(pB0,6)};pw1=(u32x4){PKW(pB0,8),PKW(pB0,10),PKW(pB0,12),PKW(pB0,14)};pw2=(u32x4){PKW(pB1,0),PKW(pB1,2),PKW(pB1,4),PKW(pB1,6)};pw3=(u32x4){PKW(pB1,8),PKW(pB1,10),PKW(pB1,12),PKW(pB1,14)};
    SBAR(); pv(o,vb0+sl_cur,PAF(0),PAF(1),PAF(2),PAF(3)); }
  #undef PKW
  #undef PAF
  #undef VFR
  #undef PIN
  #undef MX3
  #undef GAPA
  #undef GAPB
  #undef EX
  #undef VRD
  #undef KRD
  #undef STEP
  #undef ENDW
  {auto rr=__builtin_amdgcn_permlane32_swap(__float_as_uint(l_reg),__float_as_uint(l_reg),false,false);l_reg=__uint_as_float(rr[0])+__uint_as_float(rr[1]);}
  if(hi==0)wsf[32+r32]=l_reg;asm volatile("s_waitcnt lgkmcnt(0)":::"memory");
  float rli[16];
  #pragma unroll
  for(int r=0;r<16;++r)rli[r]=__builtin_amdgcn_rcpf(wsf[32+crow(r,hi)]);
  bf16*Ow=O+(rowbase+q0+wid*QBLK)*OP+h*D;
  { bf16*stg=(bf16*)(shm+LDS_OST)+wid*2048;
    #pragma unroll
    for(int r=0;r<16;++r){const int orow=crow(r,hi);
      #pragma unroll
      for(int d0=0;d0<2;++d0)stg[orow*64+d0*32+r32]=__float2bfloat16(o[d0][r]*rli[r]);}
    asm volatile("s_waitcnt lgkmcnt(0)":::"memory");
    #pragma unroll
    for(int i=0;i<4;++i){const int row=i*8+(lane>>3),ch=lane&7; const u32x4 v=*(const u32x4*)(stg+row*64+ch*8); ATTN_STORE16(Ow+(long)row*OP+ch*8,v);} }
  asm volatile("s_waitcnt lgkmcnt(0)\n\ts_barrier":::"memory");
  #undef DMA_K
  #undef DMA_V
  #undef CMASK
  #undef START
  #undef RESC
  #undef ROT
}
constexpr int ATTN_LDS_BYTES=LDS_BYTES;
struct AttnTensors { const bf16* Q; const bf16* K; const bf16* V; bf16* O; };
struct AttnUnit { int bh; int qb; };
struct StaticOrder {
  int vcu;
  __device__ __forceinline__ explicit StaticOrder(int grid,int block):vcu((block%8)*(grid/8)+block/8){}
  __device__ __forceinline__ bool next(int i,AttnUnit&u)const{ if(i>=4)return false; const int s=vcu&7; u.bh=vcu>>3; u.qb=(i==0)?s:(i==1)?15-s:(i==2)?16+s:31-s; return true; }
  __device__ __forceinline__ void a_ready(const AttnUnit&)const{}
  __device__ __forceinline__ void done(const AttnUnit&)const{}
};
template<class Sched,int THRL=8> __device__ __forceinline__ void attn_phase(char*lds,const AttnTensors&T,const Sched&S){
  AttnUnit u;
  for(int i=0;S.next(i,u);++i){ S.a_ready(u); attn_unit<THRL>(u.bh/NHEAD,u.bh%NHEAD,u.qb,T.Q,T.K,T.V,T.O,lds); S.done(u); }
}
#undef SBAR
#undef WAIT_BAR
}


namespace cg = cooperative_groups;
#define LAS __attribute__((address_space(3)))
typedef unsigned short bf16;
typedef float f32x4 __attribute__((ext_vector_type(4)));
typedef unsigned u32x4 __attribute__((ext_vector_type(4)));
typedef unsigned u32x2 __attribute__((ext_vector_type(2)));
typedef short bf16x8 __attribute__((ext_vector_type(8)));
using pg8::cvt_pk_bf16; using pg8::bflo; using pg8::bfhi; using pg8::pack8; using pg8::unpack8;

constexpr int SEQ = 8192, M = 16384, DMODEL = 1024, DEPTH = 4, INC = 9728, DFF = 2816, NWAVES = 8;
#ifndef ATTREP
#define ATTREP 0
#endif
#ifndef CONVREP
#define CONVREP 0
#endif
#ifndef DILREP
#define DILREP 0
#endif
#ifndef USE_XBAR
#define USE_XBAR 1
#endif
#ifndef SEAM_FENCES
#define SEAM_FENCES 0
#endif
#ifndef XSEAM
#define XSEAM 0
#endif
#ifndef RPT
#define RPT 0
#endif
#ifndef PHMASK
#define PHMASK 0xBEF
#endif
constexpr int NPH = 12;
constexpr size_t MiB = 1u << 20;
constexpr size_t WS_WIN = 0, WS_WBRA = 19 * MiB, WS_WBRB = 20 * MiB, WS_WBRC = 21 * MiB, WS_WGLU = 22 * MiB, WS_WOUT = 23 * MiB, WS_WUP = 25 * MiB, WS_WDOWN = 36 * MiB,
                 WS_WS1 = 42 * MiB, WS_WS2 = 66 * MiB, WS_L32 = 70 * MiB, WS_ROPEA = 71 * MiB, WS_ROPEB = 72 * MiB, WS_X = 74 * MiB, WS_H = 138 * MiB,
                 WS_QA = 170 * MiB, WS_KA = 186 * MiB, WS_VA = 202 * MiB, WS_QB = 218 * MiB, WS_KB = 266 * MiB, WS_VB = 314 * MiB, WS_CU = 362 * MiB, WS_GATES = 378 * MiB,
                 WS_OG = 474 * MiB, WS_LSE = 522 * MiB, WS_OA = 523 * MiB, WS_Y = 539 * MiB, WS_E = 571 * MiB, WS_CARRY = 579 * MiB, WS_END = 583 * MiB;
constexpr size_t WS_O16 = WS_H, WS_Z = WS_QA, WS_OC = WS_KA, WS_OB = WS_VA, WS_MF = WS_QB, WS_MB = WS_VB;
constexpr size_t WS_FA = 170 * MiB, WS_FB = 258 * MiB, WS_ACT = 346 * MiB;
constexpr int LDS_BYTES = 147456, XCH_OFF = 131072, XBST_OFF = 139264;
constexpr size_t WS_CTL = WS_END, CTL_BYTES = 16384, WS_SSQ = WS_END + MiB, WS_TOTAL = WS_END + 2 * MiB;

struct Args { const void* in[33]; float* out; unsigned char* ws; int ph_lo, ph_hi; };

using pg8::shx;
__device__ __forceinline__ float wave_sum(float v, int lane) {
#pragma unroll
    for (int o = 1; o < 64; o <<= 1) v += shx(v, o, lane);
    return v;
}
__device__ __forceinline__ int inproj_col(int n) {
    const int pn = n >> 8, p = n & 255, bj = p >> 7, wc = (p >> 5) & 3, fq = (p >> 3) & 3, j = p & 7;
    if (pn < 4) { const int d = bj ? 32 + 8 * fq + j : (j < 2 ? 2 * fq + j : (j < 4 ? 8 + 2 * fq + (j - 2) : 16 + 4 * fq + (j - 4))); return pn * 256 + wc * 64 + d; }
    if (pn >= 6 && pn < 18) { const int head = wc >> 1, w = wc & 1; const int d = w ? 64 + 32 * bj + 8 * fq + j : (bj ? 32 + 8 * fq + j : (j < 4 ? 4 * fq + j : 16 + 4 * fq + (j - 4))); return pn * 256 + head * 128 + d; }
    return n;
}
__device__ __forceinline__ int srccol(int mapid, int n) {
    if (mapid == 1) return inproj_col(n);
    if (mapid == 2) { const int pn = n >> 8, p = n & 255; return (p >> 7) * DFF + pn * 128 + (p & 127); }
    return n;
}
__device__ __forceinline__ void transpose_item(const float* W, int K, int N, bf16* WT, int mapid, LAS float* scr, int item, int lane, int ldw = 0, int koff = 0) {
    if (ldw == 0) ldw = K;
    const int nblk = N / 32, kb = item / nblk, nb = item % nblk, k0 = 64 * kb, n0 = 32 * nb;
    const int sc = srccol(mapid, n0 + (lane & 31));
    float tv[32];
#pragma unroll
    for (int i = 0; i < 32; ++i) tv[i] = W[(size_t)(k0 + 2 * i + (lane >> 5)) * N + sc];
#pragma unroll
    for (int i = 0; i < 32; ++i) scr[(2 * i + (lane >> 5)) * 33 + (lane & 31)] = tv[i];
    asm volatile("s_waitcnt lgkmcnt(0)" ::: "memory");
    const int c = lane & 7;
#pragma unroll
    for (int j = 0; j < 4; ++j) { const int n = (lane >> 3) + 8 * j; const LAS float* s = scr + (8 * c) * 33 + n;
        u32x4 o; o.x = cvt_pk_bf16(s[0 * 33], s[1 * 33]); o.y = cvt_pk_bf16(s[2 * 33], s[3 * 33]); o.z = cvt_pk_bf16(s[4 * 33], s[5 * 33]); o.w = cvt_pk_bf16(s[6 * 33], s[7 * 33]);
        *(u32x4*)(WT + (size_t)(n0 + n) * ldw + koff + k0 + 8 * c) = o; }
    asm volatile("s_waitcnt lgkmcnt(0)" ::: "memory");
}
__device__ __forceinline__ void rms_row(const float* xrow, const float* g, bf16* orow, float* ssq4, int lane) {
    const f32x4* xr = (const f32x4*)xrow + lane; const f32x4* gr = (const f32x4*)g + lane;
    f32x4 v[4]; float s = 0.f;
#pragma unroll
    for (int j = 0; j < 4; ++j) { v[j] = xr[64 * j]; s += (v[j].x * v[j].x + v[j].y * v[j].y) + (v[j].z * v[j].z + v[j].w * v[j].w); }
    const float tot = wave_sum(s, lane);
    if (lane < 4) ssq4[lane] = (lane == 0) ? tot : 0.f;
    u32x2* o8 = (u32x2*)orow + lane;
#pragma unroll
    for (int j = 0; j < 4; ++j) { const f32x4 gg = gr[64 * j]; u32x2 w; w.x = cvt_pk_bf16(v[j].x * gg.x, v[j].y * gg.y); w.y = cvt_pk_bf16(v[j].z * gg.z, v[j].w * gg.w); o8[64 * j] = w; }
}

#define XB_TMO      128
#define XB_XCNT(j)  (256  + 64 * (j))
#define XB_XSUB(j)  (1280 + 64 * (j))
#define XB_XGEN(j)  (2304 + 64 * (j))
#define XB_TOP      3328
#define XB_TOPGEN   3392
#define XCD_BAR_WORDS 3456
#define XB_SPIN_CAP (1u << 18)

__device__ __forceinline__ unsigned xb_ld(unsigned* p)              { return __hip_atomic_load(p, __ATOMIC_RELAXED, __HIP_MEMORY_SCOPE_AGENT); }
__device__ __forceinline__ unsigned xb_add(unsigned* p, unsigned v) { return __hip_atomic_fetch_add(p, v, __ATOMIC_RELAXED, __HIP_MEMORY_SCOPE_AGENT); }
__device__ __forceinline__ unsigned xb_xcc_id() { return (unsigned)__builtin_amdgcn_s_getreg((3 << 11) | 20) & 0xFu; }
#define XB_SPIN(cond, bar) do { unsigned _sp = 0; while (cond) { __builtin_amdgcn_s_sleep(1); \
    if ((++_sp & 255u) == 0u) { if (xb_ld(&(bar)[XB_TMO])) break; if (_sp > XB_SPIN_CAP) { atomicAdd(&(bar)[XB_TMO], 1u); break; } } } } while (0)

struct XcdBarrier {
    unsigned* bar; unsigned x;
    volatile LAS unsigned* st;
};

__device__ __forceinline__ XcdBarrier xcd_barrier_post(unsigned* bar, volatile LAS unsigned* st) {
    XcdBarrier b; b.bar = bar; b.x = xb_xcc_id(); b.st = st;
    if (threadIdx.x == 0) (void)xb_add(&bar[XB_XCNT(b.x)], 1u);
    return b;
}
__device__ __forceinline__ void xcd_barrier_complete(unsigned* bar, unsigned x, unsigned& nloc, unsigned& nx) {
    const unsigned G = gridDim.x * gridDim.y * gridDim.z;
    unsigned sum, cnt, mine, sp = 0u;
    for (;;) {
        sum = 0u; cnt = 0u; mine = 0u;
#pragma unroll
        for (unsigned j = 0; j < 16; ++j) { const unsigned c = xb_ld(&bar[XB_XCNT(j)]); sum += c; cnt += (c > 0u) ? 1u : 0u; mine = (j == x) ? c : mine; }
        if (sum == G) break;
        __builtin_amdgcn_s_sleep(1);
        if ((++sp & 255u) == 0u) { if (xb_ld(&bar[XB_TMO])) break; if (sp > XB_SPIN_CAP) { atomicAdd(&bar[XB_TMO], 1u); break; } }
    }
    nloc = mine > 0u ? mine : 1u; nx = cnt > 0u ? cnt : 1u;
}

__device__ __forceinline__ void xcd_barrier(const XcdBarrier& b) {
    asm volatile("s_waitcnt vmcnt(0)" ::: "memory");
    __syncthreads();
    if (threadIdx.x == 0) {
        unsigned* bar = b.bar;
        __builtin_amdgcn_s_waitcnt(0);
        unsigned nloc = b.st[0], nx = b.st[1];
        if (nloc == 0u) { xcd_barrier_complete(bar, b.x, nloc, nx); b.st[0] = nloc; b.st[1] = nx; }
        const unsigned old = xb_add(&bar[XB_XSUB(b.x)], 1u);
        const unsigned gen = old / nloc;
        if (old + 1u == (gen + 1u) * nloc) {
            __builtin_amdgcn_fence(__ATOMIC_RELEASE, "agent");
            asm volatile("s_waitcnt vmcnt(0)" ::: "memory");
            const unsigned og = xb_add(&bar[XB_TOP], 1u);
            const unsigned tg = og / nx;
            if (og + 1u == (tg + 1u) * nx) xb_add(&bar[XB_TOPGEN], 1u);
            else XB_SPIN(xb_ld(&bar[XB_TOPGEN]) == tg, bar);
            __builtin_amdgcn_fence(__ATOMIC_ACQUIRE, "agent");
            xb_add(&bar[XB_XGEN(b.x)], 1u);
            asm volatile("s_waitcnt vmcnt(0)" ::: "memory");
        } else {
            XB_SPIN(xb_ld(&bar[XB_XGEN(b.x)]) == gen, bar);
            __builtin_amdgcn_fence(__ATOMIC_ACQUIRE, "agent");
            asm volatile("s_waitcnt vmcnt(0)" ::: "memory");
        }
    }
    __syncthreads();
}

__device__ __forceinline__ void ssm_build(int g, const float* a_re, const float* a_im, const float* log_dt, const float* b_re, const float* b_im, const float* c_re, const float* c_im,
                                          bf16* W1, bf16* W2, float* L32, LAS float* sm, int tid, int half) {
    LAS float* pw_re = sm; LAS float* pw_im = sm + 2112; LAS float* bb_re = sm + 4224; LAS float* bb_im = sm + 5248; LAS float* cc_re = sm + 6272; LAS float* cc_im = sm + 7296; LAS float* kern = sm + 8320;
    const float dt = expf(log_dt[g]);
    for (int idx = tid; idx < 33 * 64; idx += 512) { const int tau = idx >> 6, p = idx & 63; const float are = a_re[g * 64 + p], aim = a_im[g * 64 + p];
        const float mag = expf(are * dt * (float)tau); float s, c; sincosf(aim * dt * (float)tau, &s, &c); pw_re[idx] = mag * c; pw_im[idx] = mag * s; }
    __syncthreads();
    for (int idx = tid; idx < 1024; idx += 512) { const int p = idx >> 4; const float are = a_re[g * 64 + p], aim = a_im[g * 64 + p];
        const float nre = pw_re[64 + p] - 1.0f, nim = pw_im[64 + p], den = are * are + aim * aim;
        const float fre = (nre * are + nim * aim) / den, fim = (nim * are - nre * aim) / den;
        const float br = b_re[(size_t)g * 1024 + idx], bi = b_im[(size_t)g * 1024 + idx];
        bb_re[idx] = fre * br - fim * bi; bb_im[idx] = fre * bi + fim * br;
        cc_re[idx] = c_re[(size_t)g * 1024 + idx]; cc_im[idx] = c_im[(size_t)g * 1024 + idx]; }
    __syncthreads();
    for (int idx = tid; idx < 8192; idx += 512) { const int tau = idx >> 8, c = (idx >> 4) & 15, c2 = idx & 15; float acc = 0.f;
        for (int p = 0; p < 64; ++p) { const float cr = cc_re[c * 64 + p], ci = cc_im[c * 64 + p], pr = pw_re[tau * 64 + p], pi = pw_im[tau * 64 + p];
            const float xr = cr * pr - ci * pi, xi = cr * pi + ci * pr; acc += xr * bb_re[p * 16 + c2] - xi * bb_im[p * 16 + c2]; }
        kern[idx] = acc; }
    __syncthreads();
    bf16* W1g = W1 + (size_t)g * 768 * 512; bf16* W2g = W2 + (size_t)g * 512 * 128;
    for (int idx = tid + half * (768 * 32); idx < (half + 1) * (768 * 32); idx += 512) { const int n = idx >> 6, q = idx & 63, s = q >> 1, c0 = (q & 1) * 8; float v[8];
        if (n < 512) { const int t = n >> 4, c = n & 15;
#pragma unroll
            for (int j = 0; j < 8; ++j) v[j] = (s <= t) ? kern[(t - s) * 256 + c * 16 + c0 + j] : 0.f; }
        else if (n < 640) { const int e = n - 512, p = e & 63; const float pr = pw_re[(31 - s) * 64 + p], pi = pw_im[(31 - s) * 64 + p];
#pragma unroll
            for (int j = 0; j < 8; ++j) { const float br = bb_re[p * 16 + c0 + j], bi = bb_im[p * 16 + c0 + j]; v[j] = (e < 64) ? (pr * br - pi * bi) : (pr * bi + pi * br); } }
        else {
#pragma unroll
            for (int j = 0; j < 8; ++j) v[j] = 0.f; }
        u32x4 o; o.x = cvt_pk_bf16(v[0], v[1]); o.y = cvt_pk_bf16(v[2], v[3]); o.z = cvt_pk_bf16(v[4], v[5]); o.w = cvt_pk_bf16(v[6], v[7]);
        *(u32x4*)(W1g + (size_t)n * 512 + q * 8) = o; }
    for (int idx = tid + half * 4096; idx < (half + 1) * 4096; idx += 512) { const int n = idx >> 4, q = idx & 15, t = n >> 4, c = n & 15; float v[8];
#pragma unroll
        for (int j = 0; j < 8; ++j) { const int k = q * 8 + j, p = k & 63; const float cr = cc_re[c * 64 + p], ci = cc_im[c * 64 + p], pr = pw_re[(t + 1) * 64 + p], pi = pw_im[(t + 1) * 64 + p];
            v[j] = (k < 64) ? (cr * pr - ci * pi) : -(cr * pi + ci * pr); }
        u32x4 o; o.x = cvt_pk_bf16(v[0], v[1]); o.y = cvt_pk_bf16(v[2], v[3]); o.z = cvt_pk_bf16(v[4], v[5]); o.w = cvt_pk_bf16(v[6], v[7]);
        *(u32x4*)(W2g + (size_t)n * 128 + q * 8) = o; }
    if (half == 0 && tid < 64) { L32[(g * 64 + tid) * 2] = pw_re[32 * 64 + tid]; L32[(g * 64 + tid) * 2 + 1] = pw_im[32 * 64 + tid]; }
    __syncthreads();
}

constexpr int KSTR = 272, VSTR = 528, DIL_VT_OFF = 256 * KSTR;
struct DilRegs { u32x4 k[8], v[8]; bf16x8 q[4]; };
__device__ __forceinline__ void dil_load(int it, const bf16* qb, const bf16* kb, const bf16* vb, DilRegs& R, int tid, int cont) {
    const int lane = tid & 63, w = __builtin_amdgcn_readfirstlane(tid >> 6), fr = lane & 15, fq = lane >> 4;
    const int b = it / 768; int r = it % 768; const int g = r >> 8; r &= 255; const int h = r >> 6, blk = r & 63;
    const int dl = 2 * g, dil = 1 << dl, res = blk & (dil - 1), n = blk >> dl;
    const size_t tokbase = (size_t)b * SEQ; const int colbase = g * 512 + h * 128;
#pragma unroll
    for (int i = 0; i < 8; ++i) if (!cont || i >= 4) { const int p = tid + 512 * i, row = p >> 4, c16 = p & 15; const int tk = ((n - 1) * 128 + row) * dil + res; const bool ok = (n > 0 || row >= 128);
        const size_t off = (tokbase + (ok ? tk : 0)) * 1536 + colbase + c16 * 8;
        const u32x4 kk = *(const u32x4*)(kb + off), vv = *(const u32x4*)(vb + off);
        R.k[i] = ok ? kk : (u32x4){0u, 0u, 0u, 0u}; R.v[i] = ok ? vv : (u32x4){0u, 0u, 0u, 0u}; }
    const int qtok = (n * 128 + 16 * w + fr) * dil + res;
#pragma unroll
    for (int kk = 0; kk < 4; ++kk) R.q[kk] = *(const bf16x8*)(qb + (tokbase + qtok) * 1536 + colbase + 32 * kk + 8 * fq);
}
__device__ __forceinline__ void dil_stage(const DilRegs& R, LAS unsigned char* L, int tid, int flip, int cont) {
    LAS unsigned char* Ks = L; LAS unsigned char* Vt = L + DIL_VT_OFF;
#pragma unroll
    for (int i = 0; i < 8; ++i) if (!cont || i >= 4) { const int p = tid + 512 * i, row = (p >> 4) ^ flip, c16 = p & 15;
        *(LAS u32x4*)(Ks + row * KSTR + c16 * 16) = R.k[i];
        const u32x4 v = R.v[i]; LAS unsigned char* d = Vt + (c16 * 8) * VSTR + ((row ^ (c16 << 2)) * 2);
        *(LAS unsigned short*)(d + 0 * VSTR) = (unsigned short)(v.x & 0xffffu); *(LAS unsigned short*)(d + 1 * VSTR) = (unsigned short)(v.x >> 16);
        *(LAS unsigned short*)(d + 2 * VSTR) = (unsigned short)(v.y & 0xffffu); *(LAS unsigned short*)(d + 3 * VSTR) = (unsigned short)(v.y >> 16);
        *(LAS unsigned short*)(d + 4 * VSTR) = (unsigned short)(v.z & 0xffffu); *(LAS unsigned short*)(d + 5 * VSTR) = (unsigned short)(v.z >> 16);
        *(LAS unsigned short*)(d + 6 * VSTR) = (unsigned short)(v.w & 0xffffu); *(LAS unsigned short*)(d + 7 * VSTR) = (unsigned short)(v.w >> 16); }
}
__device__ __forceinline__ void dil_compute(int it, const bf16x8 (&qf)[4], bf16* og, float* lse, LAS unsigned char* L, int tid, int flip) {
    const int lane = tid & 63, w = __builtin_amdgcn_readfirstlane(tid >> 6), fr = lane & 15, fq = lane >> 4;
    const int b = it / 768; int r = it % 768; const int g = r >> 8; r &= 255; const int h = r >> 6, blk = r & 63;
    const int dl = 2 * g, dil = 1 << dl, res = blk & (dil - 1), n = blk >> dl;
    const size_t tokbase = (size_t)b * SEQ;
    LAS unsigned char* Ks = L; LAS unsigned char* Vt = L + DIL_VT_OFF;
    const int qtok = (n * 128 + 16 * w + fr) * dil + res;
    f32x4 s[9];
#pragma unroll
    for (int bb = 0; bb < 9; ++bb) { s[bb] = (f32x4){0.f, 0.f, 0.f, 0.f};
#pragma unroll
        for (int kk = 0; kk < 4; ++kk) { const bf16x8 kf = *(const LAS bf16x8*)(Ks + ((16 * (w + bb) + fr) ^ flip) * KSTR + (32 * kk + 8 * fq) * 2);
            s[bb] = __builtin_amdgcn_mfma_f32_16x16x32_bf16(kf, qf[kk], s[bb], 0, 0, 0); } }
    const int qi = 16 * w + fr; float mx = -INFINITY;
#pragma unroll
    for (int bb = 0; bb < 9; ++bb)
#pragma unroll
        for (int i = 0; i < 4; ++i) { const int j = 16 * (w + bb) + 4 * fq + i; const bool ok = (j >= qi) && (j <= qi + 128) && (n > 0 || j >= 128);
            s[bb][i] = ok ? s[bb][i] : -INFINITY; mx = fmaxf(mx, s[bb][i]); }
    mx = fmaxf(mx, shx(mx, 16, lane)); mx = fmaxf(mx, shx(mx, 32, lane));
    float sum = 0.f;
#pragma unroll
    for (int bb = 0; bb < 9; ++bb)
#pragma unroll
        for (int i = 0; i < 4; ++i) { const float p = __builtin_amdgcn_exp2f(s[bb][i] - mx); s[bb][i] = p; sum += p; }
    sum += shx(sum, 16, lane); sum += shx(sum, 32, lane);
    f32x4 o[8];
#pragma unroll
    for (int db = 0; db < 8; ++db) o[db] = (f32x4){0.f, 0.f, 0.f, 0.f};
#pragma unroll
    for (int pr = 0; pr < 5; ++pr) { const int bA = pr < 4 ? 2 * pr : 7, bB = pr < 4 ? 2 * pr + 1 : 8;
        u32x4 pw; pw.x = pr < 4 ? cvt_pk_bf16(s[bA][0], s[bA][1]) : 0u; pw.y = pr < 4 ? cvt_pk_bf16(s[bA][2], s[bA][3]) : 0u; pw.z = cvt_pk_bf16(s[bB][0], s[bB][1]); pw.w = cvt_pk_bf16(s[bB][2], s[bB][3]);
        const bf16x8 pf = __builtin_bit_cast(bf16x8, pw);
#pragma unroll
        for (int db = 0; db < 8; ++db) { const LAS unsigned char* vr = Vt + (16 * db + fr) * VSTR;
            const int swz = (((2 * db + (fr >> 3)) & 15) << 2) ^ flip;
            const u32x2 va = *(const LAS u32x2*)(vr + ((16 * (w + bA) + 4 * fq) ^ swz) * 2), vc = *(const LAS u32x2*)(vr + ((16 * (w + bB) + 4 * fq) ^ swz) * 2);
            u32x4 vv; vv.x = va.x; vv.y = va.y; vv.z = vc.x; vv.w = vc.y;
            o[db] = __builtin_amdgcn_mfma_f32_16x16x32_bf16(__builtin_bit_cast(bf16x8, vv), pf, o[db], 0, 0, 0); } }
    const float inv = 1.0f / sum; const size_t orow = (size_t)g * M + tokbase + qtok;
#pragma unroll
    for (int db = 0; db < 8; ++db) { u32x2 w2; w2.x = cvt_pk_bf16(o[db][0] * inv, o[db][1] * inv); w2.y = cvt_pk_bf16(o[db][2] * inv, o[db][3] * inv);
        *(u32x2*)(og + orow * 512 + h * 128 + 16 * db + 4 * fq) = w2; }
    if (fq == 0) lse[orow * 4 + h] = (mx + __builtin_amdgcn_logf(sum)) * 0.6931471805599453f;
}

#define Wt_in ((bf16*)(ws + WS_WIN))
#define Wt_bra ((bf16*)(ws + WS_WBRA))
#define Wt_brb ((bf16*)(ws + WS_WBRB))
#define Wt_brc ((bf16*)(ws + WS_WBRC))
#define Wt_glu ((bf16*)(ws + WS_WGLU))
#define Wt_out ((bf16*)(ws + WS_WOUT))
#define Wt_up ((bf16*)(ws + WS_WUP))
#define Wt_down ((bf16*)(ws + WS_WDOWN))
#define Wt_s1 ((bf16*)(ws + WS_WS1))
#define Wt_s2 ((bf16*)(ws + WS_WS2))
#define L32 ((float*)(ws + WS_L32))
#define ropeA ((float*)(ws + WS_ROPEA))
#define ropeB ((float*)(ws + WS_ROPEB))
#define X ((float*)(ws + WS_X))
#define H ((bf16*)(ws + WS_H))
#define QA ((bf16*)(ws + WS_QA))
#define KA ((bf16*)(ws + WS_KA))
#define VA ((bf16*)(ws + WS_VA))
#define QB ((bf16*)(ws + WS_QB))
#define KB ((bf16*)(ws + WS_KB))
#define VB ((bf16*)(ws + WS_VB))
#define CU ((bf16*)(ws + WS_CU))
#define GATES ((bf16*)(ws + WS_GATES))
#define O16 ((bf16*)(ws + WS_O16))
#define OG ((bf16*)(ws + WS_OG))
#define LSE ((float*)(ws + WS_LSE))
#define OA ((bf16*)(ws + WS_OA))
#define OABC ((bf16*)(ws + WS_QB))
#define SSQ ((float*)(ws + WS_SSQ))
#define Y ((bf16*)(ws + WS_Y))
#define EB ((float*)(ws + WS_E))
#define CARRY ((bf16*)(ws + WS_CARRY))
#define Z ((bf16*)(ws + WS_Z))
#define OC ((bf16*)(ws + WS_OC))
#define OB ((bf16*)(ws + WS_OB))
#define MF ((float*)(ws + WS_MF))
#define MB ((bf16*)(ws + WS_MB))
#define FA ((bf16*)(ws + WS_FA))
#define FB ((bf16*)(ws + WS_FB))
#define ACT ((bf16*)(ws + WS_ACT))
__device__ __forceinline__ void scan_item(int b, int g, int pg, int lane, const float* L32_, const float* EB_, bf16* CARRY_) {
    const int p = pg * 4 + (lane & 3), seg = lane >> 2;
    const float lr = L32_[(g * 64 + p) * 2], li = L32_[(g * 64 + p) * 2 + 1];
    float er[16], ei[16];
#pragma unroll
    for (int j = 0; j < 16; ++j) { const float* e = EB_ + ((size_t)g * 512 + b * 256 + seg * 16 + j) * 128 + p; er[j] = e[0]; ei[j] = e[64]; }
    float sr = 0.f, si = 0.f;
#pragma unroll
    for (int j = 0; j < 16; ++j) { const float nr = lr * sr - li * si + er[j], ni = lr * si + li * sr + ei[j]; sr = nr; si = ni; }
    float pr = lr, pi = li;
#pragma unroll
    for (int q = 0; q < 4; ++q) { const float nr = pr * pr - pi * pi, ni = 2.f * pr * pi; pr = nr; pi = ni; }
#pragma unroll
    for (int d = 1; d < 16; d <<= 1) {
        const int src = (lane - 4 * d) & 63;
        const float qr = __int_as_float(__builtin_amdgcn_ds_bpermute(src << 2, __float_as_int(sr))), qi = __int_as_float(__builtin_amdgcn_ds_bpermute(src << 2, __float_as_int(si)));
        if (seg >= d) { sr += pr * qr - pi * qi; si += pr * qi + pi * qr; }
        const float nr = pr * pr - pi * pi, ni = 2.f * pr * pi; pr = nr; pi = ni;
    }
    float cr = __int_as_float(__builtin_amdgcn_ds_bpermute(((lane - 4) & 63) << 2, __float_as_int(sr))), ci = __int_as_float(__builtin_amdgcn_ds_bpermute(((lane - 4) & 63) << 2, __float_as_int(si)));
    if (seg == 0) { cr = 0.f; ci = 0.f; }
#pragma unroll
    for (int j = 0; j < 16; ++j) { bf16* c = CARRY_ + ((size_t)g * 512 + b * 256 + seg * 16 + j) * 128 + p;
        c[0] = (bf16)(cvt_pk_bf16(cr, 0.f) & 0xffffu); c[64] = (bf16)(cvt_pk_bf16(ci, 0.f) & 0xffffu);
        const float nr = lr * cr - li * ci + er[j], ni = lr * ci + li * cr + ei[j]; cr = nr; ci = ni; }
}
#define CONV_EARLY(LL, GWX, NGWX) CONV_EARLY_R(LL, GWX, NGWX, 0, 1 << 30)
#define CONV_EARLY_R(LL, GWX, NGWX, IT0, IT1) do { LAS float* scr = (LAS float*)(L + wave * 16384); \
        constexpr int I_IN = 16 * 304, I_BR = 8 * 32, I_GLU = 8 * 16, I_OUT = 16 * 32; constexpr int NIT = I_IN + 3 * I_BR + I_GLU + I_OUT; \
        for (int it = (IT0) + (GWX); it < NIT && it < (IT1); it += (NGWX)) { int r = it; \
            if (r < I_IN) { transpose_item(INF(3) + (size_t)(LL) * 1024 * INC, 1024, INC, Wt_in, 1, scr, r, lane); continue; } r -= I_IN; \
            if (r < I_BR) { transpose_item(INF(12) + (size_t)(LL) * 512 * 1024, 512, 1024, Wt_bra, 0, scr, r, lane, 1536, 0); continue; } r -= I_BR; \
            if (r < I_BR) { transpose_item(INF(15) + (size_t)(LL) * 512 * 1024, 512, 1024, Wt_bra, 0, scr, r, lane, 1536, 512); continue; } r -= I_BR; \
            if (r < I_BR) { transpose_item(INF(26) + (size_t)(LL) * 512 * 1024, 512, 1024, Wt_bra, 0, scr, r, lane, 1536, 1024); continue; } r -= I_BR; \
            if (r < I_GLU) { transpose_item(INF(24) + (size_t)(LL) * 512 * 512, 512, 512, Wt_glu, 0, scr, r, lane); continue; } r -= I_GLU; \
            transpose_item(INF(27) + (size_t)(LL) * 1024 * 1024, 1024, 1024, Wt_out, 0, scr, r, lane); } } while (0)
#define CONV_LATE(LL, GWX, NGWX) do { LAS float* scr = (LAS float*)(L + wave * 16384); \
        constexpr int I_UP = 16 * 176, I_DOWN = 44 * 32; \
        for (int it = (GWX); it < I_UP + I_DOWN; it += (NGWX)) { \
            if (it < I_UP) transpose_item(INF(29) + (size_t)(LL) * 1024 * 2 * DFF, 1024, 2 * DFF, Wt_up, 2, scr, it, lane); \
            else transpose_item(INF(32) + (size_t)(LL) * DFF * 1024, DFF, 1024, Wt_down, 0, scr, it - I_UP, lane); } } while (0)
#define SSM_BUILD(LL, GG, HH) ssm_build((GG), INF(16) + (LL) * 2048, INF(17) + (LL) * 2048, INF(18) + (LL) * 32, INF(19) + (size_t)(LL) * 32768, INF(20) + (size_t)(LL) * 32768, INF(21) + (size_t)(LL) * 32768, INF(22) + (size_t)(LL) * 32768, Wt_s1, Wt_s2, L32, (LAS float*)L, tid, (HH))
__global__ void __launch_bounds__(NWAVES * 64, 2) fwd(Args args) {
    extern __shared__ __attribute__((aligned(16))) unsigned char lds[];
    cg::grid_group grid = cg::this_grid();
    LAS unsigned char* L = (LAS unsigned char*)lds;
#if USE_XBAR
    if (threadIdx.x < 2) ((volatile LAS unsigned*)(L + XBST_OFF))[threadIdx.x] = 0u;
    __syncthreads();
    (void)xcd_barrier_post((unsigned*)(args.ws + WS_CTL), (volatile LAS unsigned*)(L + XBST_OFF));
    grid.sync();
#endif
#define INF(k) ((const float*)args.in[(k) + zz])
    for (int it2 = args.ph_lo * 2; it2 < args.ph_hi * 2; ++it2) {
        const int ph = it2 >> 1; const int l = ph / NPH, k = ph % NPH;
        if ((it2 & 1) && !((RPT >> k) & 1)) continue;
        int zz; asm volatile("s_mov_b32 %0, 0" : "=s"(zz));
        unsigned char* const ws = args.ws + zz;
        const int G = (int)gridDim.x + zz, bx = (int)blockIdx.x + zz, vcu = (G % 8 == 0) ? (bx % 8) * (G / 8) + bx / 8 : bx; const int NGW = G * NWAVES;
#define PHASE_IDS int tid = threadIdx.x; asm volatile("" : "+v"(tid)); const int lane = tid & 63, wave = __builtin_amdgcn_readfirstlane(tid >> 6); const int gw = vcu * NWAVES + wave; (void)lane; (void)gw;
        const float* xin = (l == 0) ? INF(0) : X;
        if (k == 0 && l == 0 && (PHMASK & 1)) {
            PHASE_IDS
            if (vcu < 64) SSM_BUILD(0, vcu >> 1, vcu & 1);
            CONV_EARLY(0, gw, NGW);
            if (l == 0) {
                const int* pos = (const int*)args.in[1 + zz];
                for (int idx = (vcu * 512 + tid); idx < M * 8; idx += G * 512) { const int m = idx >> 3, i = idx & 7; const float inv = expf(-(float)(2 * i) / 16.0f * 13.122363377404328f);
                    float s, c; sincosf((float)pos[m] * inv, &s, &c); ropeA[idx * 2] = c; ropeA[idx * 2 + 1] = s; }
                for (int idx = (vcu * 512 + tid); idx < M * 16; idx += G * 512) { const int m = idx >> 4, i = idx & 15; const float inv = expf(-(float)(2 * i) / 32.0f * 13.122363377404328f);
                    float s, c; sincosf((float)pos[m] * inv, &s, &c); ropeB[idx * 2] = c; ropeB[idx * 2 + 1] = s; }
            }
            if (l == 0) for (int m = gw; m < M; m += NGW) rms_row(xin + (size_t)m * 1024, INF(2) + l * 1024, H + (size_t)m * 1024, SSQ + (size_t)m * 4, lane);
        } else if (k == 1 && (PHMASK & (1 << 1))) {
            pg8::Gemm g{(const char*)H, (const char*)Wt_in, 1024, 2048, 32, 128};
            pg8::StaticOrder S; S.init(M, INC, G, bx, (size_t)256 * 2048, (size_t)256 * 1024 * 2);
            pg8::EpiInProj E{QA, KA, VA, QB, KB, VB, CU, GATES, INF(5) + l * 64, INF(6) + l * 64, INF(13) + l * 128, INF(14) + l * 128, INF(4) + l * 3072, ropeA, ropeB, (LAS float*)(L + XCH_OFF), SSQ};
            pg8::gemm_phase<pg8::EpiInProj, pg8::StaticOrder, true, true>(L, g, S, E);
            if (bx >= 128) { PHASE_IDS for (int rep_ = 0; rep_ <= CONVREP; ++rep_) CONV_LATE(l, (bx - 128) * NWAVES + wave, 128 * NWAVES); }
        } else if (k == 2 && (PHMASK & (1 << 2))) {
            PHASE_IDS
            {
                const attn_body::AttnTensors AT{(const attn_body::bf16*)QA, (const attn_body::bf16*)KA, (const attn_body::bf16*)VA, (attn_body::bf16*)O16};
                const attn_body::StaticOrder S(G, bx);
                for (int rep_ = 0; rep_ <= ATTREP; ++rep_) attn_body::attn_phase<attn_body::StaticOrder>((char*)lds, AT, S);
            }
            __syncthreads();
            for (int rep = 0; rep <= DILREP; ++rep) {
                const bool clsA = vcu >= 192, clsB = !clsA && (vcu % 3) == 2;
                const int pbase = clsA ? 384 + (vcu - 192) : (clsB ? 640 + vcu / 3 : (vcu / 3) * 2 + (vcu % 3)), pstep = (clsA || clsB) ? 64 : 128, nitem = clsA ? 8 : (clsB ? 4 : 6);
#define DIL_ITEM(s, IT) do { const int pid_ = pbase + ((s) >> 1) * pstep, b_ = pid_ / 384, r_ = pid_ % 384, g_ = r_ >> 7, h_ = (r_ >> 5) & 3, pb_ = r_ & 31, dl_ = 2 * g_; \
        IT = b_ * 768 + g_ * 256 + h_ * 64 + ((((pb_ >> dl_) * 2 + ((s) & 1)) << dl_) | (pb_ & ((1 << dl_) - 1))); } while (0)
                int it0_; DIL_ITEM(0, it0_);
                DilRegs R; dil_load(it0_, QB, KB, VB, R, tid, 0);
                for (int s = 0; s < nitem; ++s) {
                    int it; DIL_ITEM(s, it); const int cont = s & 1, flip = cont ? 128 : 0;
                    dil_stage(R, L, tid, flip, cont);
                    bf16x8 qf[4];
#pragma unroll
                    for (int kk = 0; kk < 4; ++kk) qf[kk] = R.q[kk];
                    __syncthreads();
                    if (s + 1 < nitem) { int itn; DIL_ITEM(s + 1, itn); dil_load(itn, QB, KB, VB, R, tid, (s + 1) & 1); }
                    dil_compute(it, qf, OG, LSE, L, tid, flip);
                    __syncthreads();
                }
            }
            {
                pg8::Gemm g{(const char*)CU, (const char*)Wt_s1, 512, 1024, 32, 128};
                pg8::GroupOrder S; S.init(2, 3, G, vcu, (size_t)256 * 1024, (size_t)256 * 512 * 2, (size_t)16384 * 16 * 2, (size_t)768 * 512 * 2);
                pg8::EpiSsm1 E{Y, EB};
                pg8::gemm_phase<pg8::EpiSsm1, pg8::GroupOrder, true, true>(L, g, S, E);
                if (vcu < 192 && (vcu % 3) == 2) {
                    asm volatile("s_waitcnt vmcnt(0)" ::: "memory"); __syncthreads();
                    for (int pg = wave; pg < 16; pg += NWAVES) scan_item((vcu % 6) / 3, vcu / 6, pg, lane, L32, EB, CARRY);
                }
            }
        } else if (k == 3 && (PHMASK & (1 << 3))) {
            PHASE_IDS
            {
                const float lam_init = 0.8f - 0.6f * expf(-0.3f * (float)l);
                const float d1 = wave_sum(INF(7)[l * 64 + lane] * INF(8)[l * 64 + lane], lane), d2 = wave_sum(INF(9)[l * 64 + lane] * INF(10)[l * 64 + lane], lane);
                const float lam = expf(d1) - expf(d2) + lam_init;
                const int head = lane >> 4, e8 = (lane & 15) * 8;
                f32x4 sg0 = *(const f32x4*)(INF(11) + l * 128 + e8), sg1 = *(const f32x4*)(INF(11) + l * 128 + e8 + 4);
                sg0 *= (1.0f - lam_init); sg1 *= (1.0f - lam_init);
                const int CSPLIT = 4864;
                const int half_ = (bx < 128) ? 0 : 1, gwh = (bx & 127) * NWAVES + wave;
                for (int m = (half_ ? CSPLIT : 0) + gwh; m < (half_ ? M : CSPLIT); m += 128 * NWAVES) {
                    f32x4 a0, a1, b0, b1; unpack8(*(const u32x4*)(O16 + (size_t)m * 1024 + head * 256 + e8), a0, a1); unpack8(*(const u32x4*)(O16 + (size_t)m * 1024 + head * 256 + 128 + e8), b0, b1);
                    a0 -= lam * b0; a1 -= lam * b1;
                    float ss = 0.f;
#pragma unroll
                    for (int e = 0; e < 4; ++e) ss += a0[e] * a0[e] + a1[e] * a1[e];
                    ss += shx(ss, 1, lane); ss += shx(ss, 2, lane); ss += shx(ss, 4, lane); ss += shx(ss, 8, lane);
                    const float rs = __builtin_amdgcn_rsqf(ss * (1.0f / 128.0f) + 1e-6f);
                    *(u32x4*)(OABC + (size_t)m * 1536 + head * 128 + e8) = pack8(a0 * rs * sg0, a1 * rs * sg1);
                    const float l0 = LSE[((size_t)0 * M + m) * 4 + head], l1 = LSE[((size_t)1 * M + m) * 4 + head], l2 = LSE[((size_t)2 * M + m) * 4 + head];
                    const float lm = fmaxf(l0, fmaxf(l1, l2)); const float w0 = __expf(l0 - lm), w1 = __expf(l1 - lm), w2 = __expf(l2 - lm); const float wi = 1.0f / (w0 + w1 + w2);
                    f32x4 p0, p1, q0, q1, r0, r1;
                    unpack8(*(const u32x4*)(OG + ((size_t)0 * M + m) * 512 + head * 128 + e8), p0, p1); unpack8(*(const u32x4*)(OG + ((size_t)1 * M + m) * 512 + head * 128 + e8), q0, q1);
                    unpack8(*(const u32x4*)(OG + ((size_t)2 * M + m) * 512 + head * 128 + e8), r0, r1);
                    p0 = (p0 * w0 + q0 * w1 + r0 * w2) * wi; p1 = (p1 * w0 + q1 * w1 + r1 * w2) * wi;
                    *(u32x4*)(OABC + (size_t)m * 1536 + 512 + head * 128 + e8) = pack8(p0, p1);
                }
            }
            {
                pg8::Gemm g{(const char*)CARRY, (const char*)Wt_s2, 128, 256, 32, 128};
                pg8::GroupOrder S; S.init(2, 2, G, bx, (size_t)256 * 256, (size_t)256 * 128 * 2, (size_t)512 * 128 * 2, (size_t)512 * 128 * 2);
                pg8::EpiSsm2 E{Y, CU, INF(23) + l * 512, Z};
                pg8::gemm_phase<pg8::EpiSsm2, pg8::GroupOrder, true, true>(L, g, S, E);
            }
        } else if (k == 4 && (PHMASK & (1 << 4))) {
            pg8::Gemm g{(const char*)CARRY, (const char*)Wt_s2, 128, 8192, 32, 128};
            pg8::GroupOrder S; S.init(2, 2, G, bx, (size_t)256 * 8192, (size_t)256 * 128 * 2, 256, (size_t)512 * 128 * 2);
            pg8::EpiSsm2 E{Y, CU, INF(23) + l * 512, Z};
            pg8::gemm_phase<pg8::EpiSsm2, pg8::GroupOrder, true, true>(L, g, S, E);
        } else if (k == 5 && (PHMASK & (1 << 5))) {
            pg8::Gemm g{(const char*)Z, (const char*)Wt_glu, 512, 1024, 32, 128};
            pg8::StaticOrder S; S.init(M, 512, G, bx, (size_t)256 * 1024, (size_t)256 * 512 * 2);
            pg8::EpiGlu E{Z, INF(25) + l * 512, OABC + 1024, 1536};
            pg8::gemm_phase<pg8::EpiGlu, pg8::StaticOrder, true, true>(L, g, S, E);
            if (bx >= 128 && l + 1 < DEPTH) { PHASE_IDS
                if (bx < 192) SSM_BUILD(l + 1, (bx - 128) >> 1, (bx - 128) & 1); else CONV_EARLY_R(l + 1, (bx - 192) * NWAVES + wave, 64 * NWAVES, 0, 1536); }
        } else if (k == 6 && (PHMASK & (1 << 6))) {
            pg8::Gemm g{(const char*)OABC, (const char*)Wt_bra, 1536, 3072, 32, 128};
            pg8::StaticOrder S; S.init(M, 1024, G, bx, (size_t)256 * 3072, (size_t)256 * 1536 * 2);
            pg8::EpiMergeF E{GATES, MB};
            pg8::gemm_phase<pg8::EpiMergeF, pg8::StaticOrder, true, true>(L, g, S, E);
        } else if (k == 7 && (PHMASK & (1 << 7))) {
            pg8::Gemm g{(const char*)MB, (const char*)Wt_out, 1024, 2048, 32, 128};
            pg8::StaticOrder S; S.init(M, 1024, G, bx, (size_t)256 * 2048, (size_t)256 * 1024 * 2);
            if ((RPT & 0x80) && !(it2 & 1)) { pg8::EpiResid E{xin, (float*)(ws + WS_OG)}; pg8::gemm_phase<pg8::EpiResid, pg8::StaticOrder, true, true>(L, g, S, E); } else {
            pg8::EpiResidN E{xin, X, INF(28) + l * 1024, H, SSQ, (LAS float*)(L + XCH_OFF)};
            pg8::gemm_phase<pg8::EpiResidN, pg8::StaticOrder, true, true>(L, g, S, E); }
        } else if (k == 8 && (PHMASK & (1 << 8))) {
            PHASE_IDS
        } else if (k == 9 && (PHMASK & (1 << 9))) {
            pg8::Gemm g{(const char*)H - 2 * 2048, (const char*)Wt_up, 1024, 2048, 32, 128};
            pg8::StaticOrder S; S.init_tiles(65, 22, G, bx, (size_t)254 * 2048, (size_t)256 * 1024 * 2);
            pg8::EpiUpConv E{ACT, SSQ, INF(30) + (size_t)l * 3 * DFF, INF(31) + (size_t)l * DFF, (LAS float*)(L + XCH_OFF)};
            pg8::gemm_phase<pg8::EpiUpConv, pg8::StaticOrder, true, true>(L, g, S, E);
            if (bx >= 150 && l + 1 < DEPTH) { PHASE_IDS for (int rep_ = 0; rep_ <= CONVREP; ++rep_) { CONV_EARLY_R(l + 1, (bx - 150) * NWAVES + wave, 106 * NWAVES, 1536, 1 << 30); } }
        } else if (k == 10 && (PHMASK & (1 << 10))) {
            PHASE_IDS
            const float* cw = INF(30) + (size_t)l * 3 * DFF; const float* cb = INF(31) + (size_t)l * DFF;
            for (int it = vcu * 512 + tid; it < 2048 * 352; it += G * 512) {
                const int cc = it % 352, rr = it / 352, t0 = rr * 8, col = cc * 8;
                u32x4 ra[10], rb[8];
                const bool first = (t0 & (SEQ - 1)) == 0;
                ra[0] = first ? (u32x4){0u, 0u, 0u, 0u} : *(const u32x4*)(FA + (size_t)(t0 - 2) * DFF + col);
                ra[1] = first ? (u32x4){0u, 0u, 0u, 0u} : *(const u32x4*)(FA + (size_t)(t0 - 1) * DFF + col);
#pragma unroll
                for (int t = 0; t < 8; ++t) { ra[t + 2] = *(const u32x4*)(FA + (size_t)(t0 + t) * DFF + col); rb[t] = *(const u32x4*)(FB + (size_t)(t0 + t) * DFF + col); }
                const f32x4 w0a = *(const f32x4*)(cw + col), w0b = *(const f32x4*)(cw + col + 4), w1a = *(const f32x4*)(cw + DFF + col), w1b = *(const f32x4*)(cw + DFF + col + 4);
                const f32x4 w2a = *(const f32x4*)(cw + 2 * DFF + col), w2b = *(const f32x4*)(cw + 2 * DFF + col + 4), ba = *(const f32x4*)(cb + col), bb = *(const f32x4*)(cb + col + 4);
                f32x4 h2a, h2b, h1a, h1b; unpack8(ra[0], h2a, h2b); unpack8(ra[1], h1a, h1b);
#pragma unroll
                for (int t = 0; t < 8; ++t) {
                    f32x4 ca, cb2, ga, gb; unpack8(ra[t + 2], ca, cb2); unpack8(rb[t], ga, gb);
                    f32x4 va = ba + w0a * h2a + w1a * h1a + w2a * ca, vb2 = bb + w0b * h2b + w1b * h1b + w2b * cb2;
#pragma unroll
                    for (int e = 0; e < 4; ++e) { va[e] = va[e] * pg8::sigmoidf_(va[e]) * ga[e]; vb2[e] = vb2[e] * pg8::sigmoidf_(vb2[e]) * gb[e]; }
                    *(u32x4*)(ACT + (size_t)(t0 + t) * DFF + col) = pack8(va, vb2);
                    h2a = h1a; h2b = h1b; h1a = ca; h1b = cb2;
                }
            }
        } else if (k == 11 && (PHMASK & (1 << 11))) {
            pg8::Gemm g{(const char*)ACT, (const char*)Wt_down, DFF, 2 * DFF, 32, 128};
            pg8::StaticOrder S; S.init(M, 1024, G, bx, (size_t)256 * 2 * DFF, (size_t)256 * DFF * 2);
            if ((RPT & 0x800) && !(it2 & 1)) { pg8::EpiResid E{X, (float*)(ws + WS_OG)}; pg8::gemm_phase<pg8::EpiResid, pg8::StaticOrder, true, true>(L, g, S, E); }
            else if (l == DEPTH - 1) { pg8::EpiResid E{X, args.out + zz}; pg8::gemm_phase<pg8::EpiResid, pg8::StaticOrder, true, true>(L, g, S, E); }
            else { pg8::EpiResidN E{X, X, INF(2) + (l + 1) * 1024, H, SSQ, (LAS float*)(L + XCH_OFF)}; pg8::gemm_phase<pg8::EpiResidN, pg8::StaticOrder, true, true>(L, g, S, E); }
        }
        if (k == 4 || k == 8 || k == 10 || (k == 0 && l > 0)) continue;
        if (it2 + 2 < args.ph_hi * 2 || (RPT != 0 && it2 + 1 < args.ph_hi * 2)) for (int xs = 0; xs <= XSEAM; ++xs) {
#if SEAM_FENCES
            __builtin_amdgcn_fence(__ATOMIC_RELEASE, "agent"); asm volatile("s_waitcnt vmcnt(0) lgkmcnt(0)" ::: "memory");
            grid.sync();
            __builtin_amdgcn_fence(__ATOMIC_ACQUIRE, "agent"); asm volatile("s_waitcnt vmcnt(0) lgkmcnt(0)" ::: "memory");
            __syncthreads();
#elif USE_XBAR
            { XcdBarrier xb_; xb_.bar = (unsigned*)(ws + WS_CTL); xb_.x = xb_xcc_id(); xb_.st = (volatile LAS unsigned*)(L + XBST_OFF); xcd_barrier(xb_); }
#else
            grid.sync();
#endif
        }
    }
#undef INF
}

extern "C" void kernel_launch(void* const* d_in, const int* in_sizes, int n_in, void* d_out, int out_size, void* d_ws, size_t ws_size, hipStream_t stream) {
    static int grid = 0;
    if (grid == 0) {
        if (n_in != 33 || in_sizes[0] != M * DMODEL || out_size != M * DMODEL || ws_size < WS_TOTAL) { fprintf(stderr, "kernel_launch: unexpected shapes/workspace (n_in %d, ws %zu < %zu)\n", n_in, ws_size, (size_t)WS_END); grid = -1; return; }
        int dev = 0, cus = 0, per_cu = 0;
        if (hipGetDevice(&dev) != hipSuccess || hipDeviceGetAttribute(&cus, hipDeviceAttributeMultiprocessorCount, dev) != hipSuccess) { grid = -1; return; }
        if (hipFuncSetAttribute((const void*)fwd, hipFuncAttributeMaxDynamicSharedMemorySize, LDS_BYTES) != hipSuccess) { fprintf(stderr, "kernel_launch: hipFuncSetAttribute failed\n"); grid = -1; return; }
        if (hipOccupancyMaxActiveBlocksPerMultiprocessor(&per_cu, (const void*)fwd, NWAVES * 64, LDS_BYTES) != hipSuccess || per_cu < 1) per_cu = 1;
        (void)hipGetLastError();
        grid = cus;
    }
    if (grid < 0) return;
    if (hipMemsetAsync((char*)d_ws + WS_CTL, 0, CTL_BYTES, stream) != hipSuccess) { fprintf(stderr, "kernel_launch: memset of the barrier words failed\n"); return; }
    Args a{};
    for (int i = 0; i < 33; ++i) a.in[i] = d_in[i];
    a.out = (float*)d_out; a.ws = (unsigned char*)d_ws; a.ph_lo = 0; a.ph_hi = DEPTH * NPH;
    void* kargs[] = {&a};
    hipError_t e = hipLaunchCooperativeKernel((const void*)fwd, dim3(grid), dim3(NWAVES * 64), kargs, LDS_BYTES, stream);
    if (e != hipSuccess) fprintf(stderr, "kernel_launch: cooperative launch failed: %s (grid %d)\n", hipGetErrorString(e), grid);
}
```

```cpp
#include <hip/hip_runtime.h>
#include <hip/hip_cooperative_groups.h>
#include <cstdio>
#include <cstdint>
namespace pg8 {
#define PG8_LAS __attribute__((address_space(3)))
typedef unsigned short bf16_t;
typedef short bf16x8 __attribute__((ext_vector_type(8)));
typedef float f32x4 __attribute__((ext_vector_type(4)));
typedef unsigned u32x4 __attribute__((ext_vector_type(4)));
constexpr int BM = 256, BK = 64, HALF = 128, HTB = HALF * BK * 2  , STAGE_BYTES = 8 * HTB, NXCD = 8, WGM = 8;

__host__ __device__ __forceinline__ int lds_byte(int r, int c) { const int st = (r >> 4) * 2 + (c >> 5), rr = r & 15, cc = c & 31, ob = rr * 64 + cc * 2; return st * 1024 + (ob ^ (((ob >> 9) & 1) << 5)); }
__host__ __device__ __forceinline__ void stage_rc(int b, int& R, int& C) { const int st = b / 1024, sb = b % 1024, swz = sb ^ (((sb >> 9) & 1) << 5); R = (st >> 1) * 16 + swz / 64; C = (st & 1) * 32 + (swz % 64) / 2; }
__host__ __device__ __forceinline__ int perm32(int rho) { const int n = rho >> 4, i = rho & 15; return 8 * (i >> 2) + 4 * n + (i & 3); }


typedef unsigned u32x2 __attribute__((ext_vector_type(2)));
struct Unit { int pm, pn, g; };
struct Gemm { const char* A; const char* Bt; int K; int a_row, a_c16, a_kt; };

struct StaticOrder {
    int nM, nN, nwg, G, c; size_t ta, tb;
    __device__ void init(int M, int N, int G_, int c_, size_t ta_, size_t tb_) { nM = M / BM; nN = N / BM; nwg = nM * nN; G = G_; c = c_; ta = ta_; tb = tb_; }
    __device__ void init_tiles(int nM_, int nN_, int G_, int c_, size_t ta_, size_t tb_) { nM = nM_; nN = nN_; nwg = nM * nN; G = G_; c = c_; ta = ta_; tb = tb_; }
    __device__ bool next(int i, Unit& u) const {
        const long L = (long)i * G + c; if (L >= nwg) return false;
        int wgid = (int)L; { const int q = nwg / NXCD, r = nwg % NXCD, xcd = wgid % NXCD, off = wgid / NXCD; wgid = (xcd < r ? xcd * (q + 1) : r * (q + 1) + (xcd - r) * q) + off; }
        const int nig = WGM * nN, gid = wgid / nig, fm = gid * WGM, gsz = (nM - fm) < WGM ? (nM - fm) : WGM;
        u.pm = fm + ((wgid % nig) % gsz); u.pn = (wgid % nig) / gsz; u.g = 0; return true;
    }
    __device__ __forceinline__ size_t offA(const Unit& u) const { return (size_t)u.pm * ta; }
    __device__ __forceinline__ size_t offB(const Unit& u) const { return (size_t)u.pn * tb; }
};
struct GroupOrder {
    int nM, nN, nwg, G, c; size_t ta, tb, ga, gb;
    __device__ void init(int nM_, int nN_, int G_, int c_, size_t ta_, size_t tb_, size_t ga_, size_t gb_) { nM = nM_; nN = nN_; nwg = 32 * nM_ * nN_; G = G_; c = c_; ta = ta_; tb = tb_; ga = ga_; gb = gb_; }
    __device__ bool next(int i, Unit& u) const {
        const long L = (long)i * G + c; if (L >= nwg) return false;
        const int per = nM * nN, g = (int)L / per, r = (int)L % per; u.g = g; u.pm = r / nN; u.pn = r % nN; return true;
    }
    __device__ __forceinline__ size_t offA(const Unit& u) const { return (size_t)u.g * ga + (size_t)u.pm * ta; }
    __device__ __forceinline__ size_t offB(const Unit& u) const { return (size_t)u.g * gb + (size_t)u.pn * tb; }
};

typedef float f32x2cv __attribute__((ext_vector_type(2))); typedef __bf16 bf16x2cv __attribute__((ext_vector_type(2)));
__device__ __forceinline__ unsigned cvt_pk_bf16(float lo, float hi) { f32x2cv v = {lo, hi}; bf16x2cv b = __builtin_convertvector(v, bf16x2cv); return __builtin_bit_cast(unsigned, b); }
__device__ __forceinline__ float shx(float v, int mask, int lane) { return __int_as_float(__builtin_amdgcn_ds_bpermute((lane ^ mask) << 2, __float_as_int(v))); }
__device__ __forceinline__ float bflo(unsigned w) { return __uint_as_float(w << 16); }
__device__ __forceinline__ float bfhi(unsigned w) { return __uint_as_float(w & 0xffff0000u); }
__device__ __forceinline__ float sigmoidf_(float x) { return __builtin_amdgcn_rcpf(1.0f + __builtin_amdgcn_exp2f(-1.4426950408889634f * x)); }
__device__ __forceinline__ float gelu_tanh(float v) { const float a = 0.7978845608028654f * (v + 0.044715f * v * v * v); const float t = 1.0f - 2.0f * __builtin_amdgcn_rcpf(1.0f + __builtin_amdgcn_exp2f(2.0f * 1.4426950408889634f * a)); return 0.5f * v * (1.0f + t); }
__device__ __forceinline__ u32x4 pack8(const f32x4 a, const f32x4 b) { u32x4 w; w.x = cvt_pk_bf16(a[0], a[1]); w.y = cvt_pk_bf16(a[2], a[3]); w.z = cvt_pk_bf16(b[0], b[1]); w.w = cvt_pk_bf16(b[2], b[3]); return w; }
__device__ __forceinline__ void unpack8(const u32x4 w, f32x4& a, f32x4& b) { a = (f32x4){bflo(w.x), bfhi(w.x), bflo(w.y), bfhi(w.y)}; b = (f32x4){bflo(w.z), bfhi(w.z), bflo(w.w), bfhi(w.w)}; }

#define EPI_ROWS_BEGIN _Pragma("unroll") for (int ai = 0; ai < 2; ++ai) _Pragma("unroll") for (int m = 0; m < 4; ++m) { const int rt = ai * 128 + wr * 64 + m * 16 + fr; const int row = u.pm * 256 + rt; (void)row;
#define EPI_ROWS_END if (m == 3) asm volatile("" ::: "memory"); }

__device__ __forceinline__ void row_rstd(float (&rs)[8], const float* ssq, const Unit& u, int wr, int fr) {
    f32x4 q[8];
#pragma unroll
    for (int i = 0; i < 8; ++i) q[i] = *(const f32x4*)(ssq + (size_t)(u.pm * 256 + (i >> 2) * 128 + wr * 64 + (i & 3) * 16 + fr) * 4);
#pragma unroll
    for (int i = 0; i < 8; ++i) rs[i] = __builtin_amdgcn_rsqf(((q[i][0] + q[i][1]) + (q[i][2] + q[i][3])) * (1.0f / 1024.0f) + 1e-6f);
}
struct EpiInProj {
    static constexpr bool PERM = true, HOOK = false, PRE = true;
    bf16_t *qa, *ka, *va, *qb, *kb, *vb, *cu, *gates;
    const float *qn_a, *kn_a, *qn_b, *kn_b, *b_gate, *ropeA, *ropeB;
    PG8_LAS float* xch;
    const float* ssq;
    __device__ __forceinline__ void plain(const f32x4 (&acc)[2][2][4][2], const float (&rsr)[8], const Unit& u, int wr, int wc, int fr, int fq, bf16_t* dst, int ld, int tl) const {
        EPI_ROWS_BEGIN
#pragma unroll
            for (int bj = 0; bj < 2; ++bj) *(u32x4*)(dst + (size_t)row * ld + tl * 256 + bj * 128 + wc * 32 + 8 * fq) = pack8(acc[ai][bj][m][0] * rsr[ai * 4 + m], acc[ai][bj][m][1] * rsr[ai * 4 + m]);
        EPI_ROWS_END
    }
    __device__ __forceinline__ void plain_va(const f32x4 (&acc)[2][2][4][2], const float (&rsr)[8], const Unit& u, int wr, int wc, int fr, int fq, int tl) const {
        EPI_ROWS_BEGIN
#pragma unroll
            for (int bj = 0; bj < 2; ++bj) { const int col = tl * 256 + bj * 128 + wc * 32 + 8 * fq;
                *(u32x4*)(va + ((size_t)(col >> 7) * 16384 + row) * 128 + (col & 127)) = pack8(acc[ai][bj][m][0] * rsr[ai * 4 + m], acc[ai][bj][m][1] * rsr[ai * 4 + m]); }
        EPI_ROWS_END
    }
    __device__ __forceinline__ void plain_cu(const f32x4 (&acc)[2][2][4][2], const float (&rsr)[8], const Unit& u, int wr, int wc, int fr, int fq, int tl) const {
        EPI_ROWS_BEGIN
#pragma unroll
            for (int bj = 0; bj < 2; ++bj) { const int col = tl * 256 + bj * 128 + wc * 32 + 8 * fq;
                *(u32x4*)(cu + ((size_t)(col >> 4) * 16384 + row) * 16 + (col & 15)) = pack8(acc[ai][bj][m][0] * rsr[ai * 4 + m], acc[ai][bj][m][1] * rsr[ai * 4 + m]); }
        EPI_ROWS_END
    }
    __device__ __forceinline__ void gate(const f32x4 (&acc)[2][2][4][2], const float (&rsr)[8], const Unit& u, int wr, int wc, int fr, int fq, int tl) const {
        f32x4 bv[2][2];
#pragma unroll
        for (int bj = 0; bj < 2; ++bj) { const float* bp = b_gate + tl * 256 + bj * 128 + wc * 32 + 8 * fq; bv[bj][0] = *(const f32x4*)bp; bv[bj][1] = *(const f32x4*)(bp + 4); }
        EPI_ROWS_BEGIN
#pragma unroll
            for (int bj = 0; bj < 2; ++bj) { f32x4 a = acc[ai][bj][m][0] * rsr[ai * 4 + m] + bv[bj][0], b = acc[ai][bj][m][1] * rsr[ai * 4 + m] + bv[bj][1];
#pragma unroll
                for (int e = 0; e < 4; ++e) { a[e] = sigmoidf_(a[e]); b[e] = sigmoidf_(b[e]); }
                *(u32x4*)(gates + (size_t)row * 3072 + tl * 256 + bj * 128 + wc * 32 + 8 * fq) = pack8(a, b); }
        EPI_ROWS_END
    }
    __device__ __forceinline__ void norm64(const f32x4 (&acc)[2][2][4][2], const float (&rsr)[8], const Unit& u, int wr, int wc, int fr, int fq, bf16_t* dst, const float* gain, float qs, int tl) const {
        f32x4 g00, g01, g10, g11;
        g00 = (f32x4){gain[2 * fq], gain[2 * fq + 1], gain[8 + 2 * fq], gain[9 + 2 * fq]};
        g01 = *(const f32x4*)(gain + 16 + 4 * fq); g10 = *(const f32x4*)(gain + 32 + 8 * fq); g11 = *(const f32x4*)(gain + 36 + 8 * fq);
        g00 *= qs; g01 *= qs; g10 *= qs; g11 *= qs;
        EPI_ROWS_BEGIN
            const float rw = rsr[ai * 4 + m]; f32x4 v00 = acc[ai][0][m][0] * rw, v01 = acc[ai][0][m][1] * rw, v10 = acc[ai][1][m][0] * rw, v11 = acc[ai][1][m][1] * rw;
            float ss = 0.f;
#pragma unroll
            for (int e = 0; e < 4; ++e) ss += v00[e] * v00[e] + v01[e] * v01[e] + v10[e] * v10[e] + v11[e] * v11[e];
            ss += shx(ss, 16, fq * 16 + fr); ss += shx(ss, 32, fq * 16 + fr);
            const float rs = __builtin_amdgcn_rsqf(ss * (1.0f / 64.0f) + 1e-6f);
            v00 = v00 * rs * g00; v01 = v01 * rs * g01; v10 = v10 * rs * g10; v11 = v11 * rs * g11;
            const f32x4 cs = *(const f32x4*)(ropeA + (size_t)row * 16 + 4 * fq);
            const float o0 = v00[0] * cs[0] - v00[2] * cs[1], o2 = v00[2] * cs[0] + v00[0] * cs[1];
            const float o1 = v00[1] * cs[2] - v00[3] * cs[3], o3 = v00[3] * cs[2] + v00[1] * cs[3];
            bf16_t* base = dst + ((size_t)(tl * 4 + wc) * 16384 + row) * 64;
            *(unsigned*)(base + 2 * fq) = cvt_pk_bf16(o0, o1);
            *(unsigned*)(base + 8 + 2 * fq) = cvt_pk_bf16(o2, o3);
            u32x2 w2; w2.x = cvt_pk_bf16(v01[0], v01[1]); w2.y = cvt_pk_bf16(v01[2], v01[3]);
            *(u32x2*)(base + 16 + 4 * fq) = w2;
            *(u32x4*)(base + 32 + 8 * fq) = pack8(v10, v11);
        EPI_ROWS_END
    }
    __device__ __forceinline__ void norm128(const f32x4 (&acc)[2][2][4][2], const float (&rsr)[8], const Unit& u, int wr, int wc, int fr, int fq, bf16_t* dst, const float* gain, float qs, int tl) const {
        const int w = wc & 1, head = wc >> 1;
        const int d00 = w ? 64 + 8 * fq : 4 * fq, d01 = w ? 68 + 8 * fq : 16 + 4 * fq, d1 = w ? 96 + 8 * fq : 32 + 8 * fq;
        f32x4 g00 = *(const f32x4*)(gain + d00), g01 = *(const f32x4*)(gain + d01), g10 = *(const f32x4*)(gain + d1), g11 = *(const f32x4*)(gain + d1 + 4);
        g00 *= qs; g01 *= qs; g10 *= qs; g11 *= qs;
        float ssr[8];
        EPI_ROWS_BEGIN
            const float rw = rsr[ai * 4 + m]; const f32x4 v00 = acc[ai][0][m][0] * rw, v01 = acc[ai][0][m][1] * rw, v10 = acc[ai][1][m][0] * rw, v11 = acc[ai][1][m][1] * rw;
            float ss = 0.f;
#pragma unroll
            for (int e = 0; e < 4; ++e) ss += v00[e] * v00[e] + v01[e] * v01[e] + v10[e] * v10[e] + v11[e] * v11[e];
            ss += shx(ss, 16, fq * 16 + fr); ss += shx(ss, 32, fq * 16 + fr);
            ssr[ai * 4 + m] = ss;
            if (fq == 0) xch[rt * 4 + wc] = ss;
        EPI_ROWS_END
        asm volatile("s_waitcnt lgkmcnt(0)" ::: "memory"); __builtin_amdgcn_s_barrier(); asm volatile("" ::: "memory");
        EPI_ROWS_BEGIN
            const float rw = rsr[ai * 4 + m]; f32x4 v00 = acc[ai][0][m][0] * rw, v01 = acc[ai][0][m][1] * rw, v10 = acc[ai][1][m][0] * rw, v11 = acc[ai][1][m][1] * rw;
            const float tot = ssr[ai * 4 + m] + xch[rt * 4 + (wc ^ 1)];
            const float rs = __builtin_amdgcn_rsqf(tot * (1.0f / 128.0f) + 1e-6f);
            v00 = v00 * rs * g00; v01 = v01 * rs * g01; v10 = v10 * rs * g10; v11 = v11 * rs * g11;
            if (w == 0) {
                const f32x4 c0 = *(const f32x4*)(ropeB + (size_t)row * 32 + 8 * fq), c1 = *(const f32x4*)(ropeB + (size_t)row * 32 + 8 * fq + 4);
                const float cc[4] = {c0[0], c0[2], c1[0], c1[2]}, sn[4] = {c0[1], c0[3], c1[1], c1[3]};
#pragma unroll
                for (int e = 0; e < 4; ++e) { const float x1 = v00[e], x2 = v01[e]; v00[e] = x1 * cc[e] - x2 * sn[e]; v01[e] = x2 * cc[e] + x1 * sn[e]; }
            }
            bf16_t* base = dst + (size_t)row * 1536 + tl * 256 + head * 128;
            u32x2 a2; a2.x = cvt_pk_bf16(v00[0], v00[1]); a2.y = cvt_pk_bf16(v00[2], v00[3]); *(u32x2*)(base + d00) = a2;
            u32x2 b2; b2.x = cvt_pk_bf16(v01[0], v01[1]); b2.y = cvt_pk_bf16(v01[2], v01[3]); *(u32x2*)(base + d01) = b2;
            *(u32x4*)(base + d1) = pack8(v10, v11);
        EPI_ROWS_END
    }
    __device__ __forceinline__ void prefetch(f32x4 (&q)[8], const Unit& u, int wr, int fr) const {
#pragma unroll
        for (int i = 0; i < 8; ++i) q[i] = *(const f32x4*)(ssq + (size_t)(u.pm * 256 + (i >> 2) * 128 + wr * 64 + (i & 3) * 16 + fr) * 4);
    }
    __device__ __forceinline__ void run(const f32x4 (&acc)[2][2][4][2], const f32x4 (&q)[8], const Unit& u, int wr, int wc, int fr, int fq) const {
        const int pn = u.pn; float rsr[8];
#pragma unroll
        for (int i = 0; i < 8; ++i) rsr[i] = __builtin_amdgcn_rsqf(((q[i][0] + q[i][1]) + (q[i][2] + q[i][3])) * (1.0f / 1024.0f) + 1e-6f);
        if (pn < 2) norm64(acc, rsr, u, wr, wc, fr, fq, qa, qn_a, 0.125f * 1.4426950408889634f, pn);
        else if (pn < 4) norm64(acc, rsr, u, wr, wc, fr, fq, ka, kn_a, 1.0f, pn - 2);
        else if (pn < 6) plain_va(acc, rsr, u, wr, wc, fr, fq, pn - 4);
        else if (pn < 12) norm128(acc, rsr, u, wr, wc, fr, fq, qb, qn_b, 0.08838834764831845f * 1.4426950408889634f, pn - 6);
        else if (pn < 18) norm128(acc, rsr, u, wr, wc, fr, fq, kb, kn_b, 1.0f, pn - 12);
        else if (pn < 24) plain(acc, rsr, u, wr, wc, fr, fq, vb, 1536, pn - 18);
        else if (pn < 26) plain_cu(acc, rsr, u, wr, wc, fr, fq, pn - 24);
        else gate(acc, rsr, u, wr, wc, fr, fq, pn - 26);
    }
};

struct EpiSsm1 {
    static constexpr bool PERM = true, HOOK = false, PRE = false;
    bf16_t* y; float* E;
    __device__ __forceinline__ void operator()(const f32x4 (&acc)[2][2][4][2], const Unit& u, int wr, int wc, int fr, int fq) const {
        const int g = u.g;
        if (u.pn < 2) {
            EPI_ROWS_BEGIN
#pragma unroll
                for (int bj = 0; bj < 2; ++bj) { const int nidx = u.pn * 256 + bj * 128 + wc * 32 + 8 * fq, t = nidx >> 4, c = nidx & 15;
                    *(u32x4*)(y + ((size_t)g * 16384 + (size_t)row * 32 + t) * 16 + c) = pack8(acc[ai][bj][m][0], acc[ai][bj][m][1]); }
            EPI_ROWS_END
        } else {
            EPI_ROWS_BEGIN
                float* p = E + ((size_t)g * 512 + row) * 128 + wc * 32 + 8 * fq; *(f32x4*)p = acc[ai][0][m][0]; *(f32x4*)(p + 4) = acc[ai][0][m][1];
            EPI_ROWS_END
        }
    }
};
struct EpiSsm2 {
    static constexpr bool PERM = true, HOOK = false, PRE = false;
    const bf16_t* y; const bf16_t* cu; const float* dsk; bf16_t* z;
    __device__ __forceinline__ void operator()(const f32x4 (&acc)[2][2][4][2], const Unit& u, int wr, int wc, int fr, int fq) const {
        const int g = u.g;
        EPI_ROWS_BEGIN
#pragma unroll
            for (int bj = 0; bj < 2; ++bj) { const int nidx = u.pn * 256 + bj * 128 + wc * 32 + 8 * fq, t = nidx >> 4, c = nidx & 15;
                const size_t off = ((size_t)row * 32 + t) * 512 + 16 * g + c, offg = ((size_t)g * 16384 + (size_t)row * 32 + t) * 16 + c;
                f32x4 ya, yb; unpack8(*(const u32x4*)(y + offg), ya, yb); f32x4 a = acc[ai][bj][m][0] + ya, b = acc[ai][bj][m][1] + yb;
                f32x4 ua, ub; unpack8(*(const u32x4*)(cu + offg), ua, ub);
                a += ua * *(const f32x4*)(dsk + 16 * g + c); b += ub * *(const f32x4*)(dsk + 16 * g + c + 4);
#pragma unroll
                for (int e = 0; e < 4; ++e) { a[e] = gelu_tanh(a[e]); b[e] = gelu_tanh(b[e]); }
                *(u32x4*)(z + off) = pack8(a, b); }
        EPI_ROWS_END
    }
};
struct EpiGlu {
    static constexpr bool PERM = true, HOOK = false, PRE = false;
    const bf16_t* z; const float* bias; bf16_t* oc; int ldo;
    __device__ __forceinline__ void operator()(const f32x4 (&acc)[2][2][4][2], const Unit& u, int wr, int wc, int fr, int fq) const {
        EPI_ROWS_BEGIN
#pragma unroll
            for (int bj = 0; bj < 2; ++bj) { const int col = u.pn * 256 + bj * 128 + wc * 32 + 8 * fq; const size_t off = (size_t)row * 512 + col;
                f32x4 a = acc[ai][bj][m][0] + *(const f32x4*)(bias + col), b = acc[ai][bj][m][1] + *(const f32x4*)(bias + col + 4);
                f32x4 za, zb; unpack8(*(const u32x4*)(z + off), za, zb);
#pragma unroll
                for (int e = 0; e < 4; ++e) { a[e] = za[e] * sigmoidf_(a[e]); b[e] = zb[e] * sigmoidf_(b[e]); }
                *(u32x4*)(oc + (size_t)row * ldo + col) = pack8(a, b); }
        EPI_ROWS_END
    }
};
template <int IDX> struct EpiMerge {
    static constexpr bool PERM = true, HOOK = false, PRE = false;
    const bf16_t* gates; float* mf; bf16_t* out;
    __device__ __forceinline__ void operator()(const f32x4 (&acc)[2][2][4][2], const Unit& u, int wr, int wc, int fr, int fq) const {
        EPI_ROWS_BEGIN
#pragma unroll
            for (int bj = 0; bj < 2; ++bj) { const int col = u.pn * 256 + bj * 128 + wc * 32 + 8 * fq; const size_t off = (size_t)row * 1024 + col;
                f32x4 ga, gb; unpack8(*(const u32x4*)(gates + (size_t)row * 3072 + IDX * 1024 + col), ga, gb);
                f32x4 a = acc[ai][bj][m][0] * ga, b = acc[ai][bj][m][1] * gb;
                if (IDX > 0) { a += *(const f32x4*)(mf + off); b += *(const f32x4*)(mf + off + 4); }
                if (IDX < 2) { *(f32x4*)(mf + off) = a; *(f32x4*)(mf + off + 4) = b; }
                else *(u32x4*)(out + off) = pack8(a, b); }
        EPI_ROWS_END
    }
};
struct EpiMergeF {
    static constexpr bool PERM = true, HOOK = true, PRE = false;
    const bf16_t* gates; bf16_t* out;
    __device__ __forceinline__ void hook(f32x4 (&acc)[2][2][4][2], const Unit& u, int t, int wr, int wc, int fr, int fq) const {
        const int nx = t >> 3;
        EPI_ROWS_BEGIN
#pragma unroll
            for (int bj = 0; bj < 2; ++bj) { const int col = u.pn * 256 + bj * 128 + wc * 32 + 8 * fq; const bf16_t* gp = gates + (size_t)row * 3072 + (nx - 1) * 1024 + col;
                f32x4 pa, pb, na, nb; unpack8(*(const u32x4*)gp, pa, pb); unpack8(*(const u32x4*)(gp + 1024), na, nb);
#pragma unroll
                for (int e = 0; e < 4; ++e) { acc[ai][bj][m][0][e] *= pa[e] * __builtin_amdgcn_rcpf(na[e]); acc[ai][bj][m][1][e] *= pb[e] * __builtin_amdgcn_rcpf(nb[e]); } }
        EPI_ROWS_END
    }
    __device__ __forceinline__ void operator()(const f32x4 (&acc)[2][2][4][2], const Unit& u, int wr, int wc, int fr, int fq) const {
        EPI_ROWS_BEGIN
#pragma unroll
            for (int bj = 0; bj < 2; ++bj) { const int col = u.pn * 256 + bj * 128 + wc * 32 + 8 * fq;
                f32x4 ga, gb; unpack8(*(const u32x4*)(gates + (size_t)row * 3072 + 2048 + col), ga, gb);
                *(u32x4*)(out + (size_t)row * 1024 + col) = pack8(acc[ai][bj][m][0] * ga, acc[ai][bj][m][1] * gb); }
        EPI_ROWS_END
    }
};
struct EpiResid {
    static constexpr bool PERM = true, HOOK = false, PRE = false;
    const float* xi; float* xo;
    __device__ __forceinline__ void operator()(const f32x4 (&acc)[2][2][4][2], const Unit& u, int wr, int wc, int fr, int fq) const {
        EPI_ROWS_BEGIN
#pragma unroll
            for (int bj = 0; bj < 2; ++bj) { const size_t off = (size_t)row * 1024 + u.pn * 256 + bj * 128 + wc * 32 + 8 * fq;
                *(f32x4*)(xo + off) = *(const f32x4*)(xi + off) + acc[ai][bj][m][0]; *(f32x4*)(xo + off + 4) = *(const f32x4*)(xi + off + 4) + acc[ai][bj][m][1]; }
        EPI_ROWS_END
    }
};
struct EpiResidN {
    static constexpr bool PERM = true, HOOK = false, PRE = false;
    const float* xi; float* xo; const float* gnext; bf16_t* hn; float* ssq; PG8_LAS float* xch;
    __device__ __forceinline__ void operator()(const f32x4 (&acc)[2][2][4][2], const Unit& u, int wr, int wc, int fr, int fq) const {
        f32x4 gv[2][2];
#pragma unroll
        for (int bj = 0; bj < 2; ++bj) { const float* gp = gnext + u.pn * 256 + bj * 128 + wc * 32 + 8 * fq; gv[bj][0] = *(const f32x4*)gp; gv[bj][1] = *(const f32x4*)(gp + 4); }
        EPI_ROWS_BEGIN
            float ss = 0.f;
#pragma unroll
            for (int bj = 0; bj < 2; ++bj) { const size_t off = (size_t)row * 1024 + u.pn * 256 + bj * 128 + wc * 32 + 8 * fq;
                const f32x4 a = *(const f32x4*)(xi + off) + acc[ai][bj][m][0], b = *(const f32x4*)(xi + off + 4) + acc[ai][bj][m][1];
                *(f32x4*)(xo + off) = a; *(f32x4*)(xo + off + 4) = b;
#pragma unroll
                for (int e = 0; e < 4; ++e) ss += a[e] * a[e] + b[e] * b[e];
                *(u32x4*)(hn + off) = pack8(a * gv[bj][0], b * gv[bj][1]); }
            ss += shx(ss, 16, fq * 16 + fr); ss += shx(ss, 32, fq * 16 + fr);
            if (fq == 0) xch[rt * 4 + wc] = ss;
        EPI_ROWS_END
        asm volatile("s_waitcnt lgkmcnt(0)" ::: "memory"); __builtin_amdgcn_s_barrier(); asm volatile("" ::: "memory");
        if (wc == 0 && fq == 0) {
            EPI_ROWS_BEGIN
                const f32x4 q = *(const PG8_LAS f32x4*)(xch + rt * 4);
                ssq[(size_t)row * 4 + u.pn] = (q[0] + q[1]) + (q[2] + q[3]);
            EPI_ROWS_END
        }
    }
};
#define DPP_SHR1(o, s) __int_as_float(__builtin_amdgcn_update_dpp(__float_as_int(o), __float_as_int(s), 0x111, 0xf, 0xf, false))
#define DPP_SHR2(o, s) __int_as_float(__builtin_amdgcn_update_dpp(__float_as_int(o), __float_as_int(s), 0x112, 0xf, 0xf, false))
#define DPP_ROR1(s) __int_as_float(__builtin_amdgcn_update_dpp(0, __float_as_int(s), 0x121, 0xf, 0xf, false))
#define DPP_ROR2(s) __int_as_float(__builtin_amdgcn_update_dpp(0, __float_as_int(s), 0x122, 0xf, 0xf, false))
struct EpiUpConv {
    static constexpr bool PERM = true, HOOK = false, PRE = true;
    bf16_t* act; const float* ssq; const float* cw; const float* cb; PG8_LAS float* xch;
    __device__ __forceinline__ void prefetch(f32x4 (&q)[8], const Unit& u, int wr, int fr) const {
#pragma unroll
        for (int i = 0; i < 8; ++i) { int gr = 254 * u.pm - 2 + (i >> 2) * 128 + wr * 64 + (i & 3) * 16 + fr; gr = gr < 0 ? 0 : (gr > 16383 ? 16383 : gr); q[i] = *(const f32x4*)(ssq + (size_t)gr * 4); }
    }
    __device__ __forceinline__ void run(const f32x4 (&acc)[2][2][4][2], const f32x4 (&q)[8], const Unit& u, int wr, int wc, int fr, int fq) const {
        const int row0 = 254 * u.pm - 2, colw = wc * 32 + 8 * fq, col = u.pn * 128 + colw;
        float rsr[8];
#pragma unroll
        for (int i = 0; i < 8; ++i) rsr[i] = __builtin_amdgcn_rsqf(((q[i][0] + q[i][1]) + (q[i][2] + q[i][3])) * (1.0f / 1024.0f) + 1e-6f);
        const f32x4 w0a = *(const f32x4*)(cw + col), w0b = *(const f32x4*)(cw + col + 4), w1a = *(const f32x4*)(cw + 2816 + col), w1b = *(const f32x4*)(cw + 2816 + col + 4);
        const f32x4 w2a = *(const f32x4*)(cw + 5632 + col), w2b = *(const f32x4*)(cw + 5632 + col + 4), ba = *(const f32x4*)(cb + col), bb = *(const f32x4*)(cb + col + 4);
#pragma unroll
        for (int ai = 0; ai < 2; ++ai) if (fr >= 14) { PG8_LAS float* p = xch + (((ai * 2 + wr) * 2 + (fr - 14)) * 128 + colw);
            *(PG8_LAS f32x4*)p = acc[ai][0][3][0] * rsr[ai * 4 + 3]; *(PG8_LAS f32x4*)(p + 4) = acc[ai][0][3][1] * rsr[ai * 4 + 3]; }
        asm volatile("s_waitcnt lgkmcnt(0)" ::: "memory"); __builtin_amdgcn_s_barrier(); asm volatile("" ::: "memory");
#pragma unroll
        for (int ai = 0; ai < 2; ++ai) {
            f32x4 pv0 = (f32x4){0.f, 0.f, 0.f, 0.f}, pv1 = pv0;
#pragma unroll
            for (int m = 0; m < 4; ++m) {
                const float rs_ = rsr[ai * 4 + m];
                const f32x4 c0 = acc[ai][0][m][0] * rs_, c1 = acc[ai][0][m][1] * rs_;
                f32x4 t1a, t1b, t2a, t2b;
                if (m == 0) {
                    const int s = ai * 2 + wr; t1a = (f32x4){0.f, 0.f, 0.f, 0.f}; t1b = t1a; t2a = t1a; t2b = t1a;
                    if (s > 0 && fr < 2) { const PG8_LAS float* pp = xch + ((s - 1) * 2) * 128 + colw;
                        const f32x4 r62a = *(const PG8_LAS f32x4*)pp, r62b = *(const PG8_LAS f32x4*)(pp + 4), r63a = *(const PG8_LAS f32x4*)(pp + 128), r63b = *(const PG8_LAS f32x4*)(pp + 132);
                        if (fr == 0) { t1a = r63a; t1b = r63b; t2a = r62a; t2b = r62b; } else { t2a = r63a; t2b = r63b; } }
                } else {
#pragma unroll
                    for (int e = 0; e < 4; ++e) { t1a[e] = DPP_ROR1(pv0[e]); t1b[e] = DPP_ROR1(pv1[e]); t2a[e] = DPP_ROR2(pv0[e]); t2b[e] = DPP_ROR2(pv1[e]); }
                }
                f32x4 p1a, p1b, p2a, p2b;
#pragma unroll
                for (int e = 0; e < 4; ++e) { p1a[e] = DPP_SHR1(t1a[e], c0[e]); p1b[e] = DPP_SHR1(t1b[e], c1[e]); p2a[e] = DPP_SHR2(t2a[e], c0[e]); p2b[e] = DPP_SHR2(t2b[e], c1[e]); }
                const int rt = ai * 128 + wr * 64 + m * 16 + fr, gr = row0 + rt, tt = gr & 8191;
                const f32x4 zero4 = (f32x4){0.f, 0.f, 0.f, 0.f};
                if (tt == 0) { p1a = zero4; p1b = zero4; } if (tt <= 1) { p2a = zero4; p2b = zero4; }
                f32x4 va = ba + w0a * p2a + w1a * p1a + w2a * c0, vb = bb + w0b * p2b + w1b * p1b + w2b * c1;
                const f32x4 ga = acc[ai][1][m][0] * rs_, gb = acc[ai][1][m][1] * rs_;
#pragma unroll
                for (int e = 0; e < 4; ++e) { va[e] = va[e] * sigmoidf_(va[e]) * ga[e]; vb[e] = vb[e] * sigmoidf_(vb[e]) * gb[e]; }
                if (rt >= 2 && gr < 16384) *(u32x4*)(act + (size_t)gr * 2816 + col) = pack8(va, vb);
                pv0 = c0; pv1 = c1;
                asm volatile("" ::: "memory");
            }
        }
    }
};
struct EpiUp {
    static constexpr bool PERM = true, HOOK = false, PRE = false;
    bf16_t* fa; bf16_t* fb; const float* ssq;
    __device__ __forceinline__ void operator()(const f32x4 (&acc)[2][2][4][2], const Unit& u, int wr, int wc, int fr, int fq) const {
        float rsr[8]; row_rstd(rsr, ssq, u, wr, fr);
        EPI_ROWS_BEGIN
            const size_t off = (size_t)row * 2816 + u.pn * 128 + wc * 32 + 8 * fq; const float rs_ = rsr[ai * 4 + m];
            *(u32x4*)(fa + off) = pack8(acc[ai][0][m][0] * rs_, acc[ai][0][m][1] * rs_);
            *(u32x4*)(fb + off) = pack8(acc[ai][1][m][0] * rs_, acc[ai][1][m][1] * rs_);
        EPI_ROWS_END
    }
};
template <class Epi, class Sched, bool ALIGN_EPI = false, bool SP2 = false>
__device__ __forceinline__ void gemm_phase(PG8_LAS unsigned char* lds, const Gemm g, const Sched& S, const Epi& E) {
    int tid_ = threadIdx.x; asm volatile("" : "+v"(tid_));
    const int tid = tid_, wid = __builtin_amdgcn_readfirstlane(tid >> 6), lane = tid & 63, wr = wid >> 2, wc = wid & 3, fr = lane & 15, fq = lane >> 4;
    const int K = g.K, nt = K / BK;
    unsigned voffA[2], voffB[2];
#pragma unroll
    for (int i = 0; i < 2; ++i) { int R, C; stage_rc(tid * 16 + i * 8192, R, C); const int Rb = Epi::PERM ? ((R & ~31) + perm32(R & 31)) : R;
        voffA[i] = (unsigned)(R * g.a_row + (C >> 4) * g.a_c16 + (C & 15) * 2); voffB[i] = (unsigned)(Rb * K + C) * 2u; }
    const size_t kstep = (size_t)(BK * 2), kstepA = (size_t)g.a_kt;
    const size_t hstep = (size_t)HALF * K * 2, hstepA = (size_t)HALF * g.a_row;
    const unsigned ldsw = (unsigned)wid * 1024u;
    const int aoff = lds_byte(wr * 64 + fr, fq * 8), boff = lds_byte(wc * 32 + fr, fq * 8);
#define PG8_SA(b, h) (((b) * 2 + (h)) * HTB)
#define PG8_SB(b, h) ((4 + (b) * 2 + (h)) * HTB)
#define PG8_STAGE(bufoff, gbase, voff) do { _Pragma("unroll") for (int _i = 0; _i < 2; ++_i) \
        __builtin_amdgcn_global_load_lds((const unsigned*)((const char*)(gbase) + (voff)[_i]), (PG8_LAS unsigned*)(lds + (bufoff) + ldsw + _i * 8192), 16, 0, 0); } while (0)
#define PG8_LDA(dst, b, h) do { _Pragma("unroll") for (int m = 0; m < 4; ++m) _Pragma("unroll") for (int k = 0; k < 2; ++k) dst[m][k] = *(const PG8_LAS bf16x8*)(lds + PG8_SA(b, h) + aoff + m * 2048 + k * 1024); } while (0)
#define PG8_LDB(dst, b, h) do { _Pragma("unroll") for (int n = 0; n < 2; ++n) _Pragma("unroll") for (int k = 0; k < 2; ++k) dst[n][k] = *(const PG8_LAS bf16x8*)(lds + PG8_SB(b, h) + boff + n * 2048 + k * 1024); } while (0)
#define PG8_MMA(ai, bj, At, Bt) do { __builtin_amdgcn_s_setprio(1); _Pragma("unroll") for (int m = 0; m < 4; ++m) _Pragma("unroll") for (int n = 0; n < 2; ++n) _Pragma("unroll") for (int k = 0; k < 2; ++k) \
        acc[ai][bj][m][n] = __builtin_amdgcn_mfma_f32_16x16x32_bf16(Bt[n][k], At[m][k], acc[ai][bj][m][n], 0, 0, 0); __builtin_amdgcn_s_setprio(0); } while (0)
#define PG8_WAIT_V(n) asm volatile("s_waitcnt vmcnt(" #n ")" ::: "memory")
#define PG8_WAIT_L(n) asm volatile("s_waitcnt lgkmcnt(" #n ")" ::: "memory")
#define PG8_BAR __builtin_amdgcn_s_barrier()
#define PG8_SCHED __builtin_amdgcn_sched_barrier(0)
    Unit cur, nxt; int ui = 0;
    if (!S.next(0, cur)) return;
    f32x4 acc[2][2][4][2];
#pragma unroll
    for (int a = 0; a < 2; ++a)
#pragma unroll
        for (int b = 0; b < 2; ++b)
#pragma unroll
            for (int m = 0; m < 4; ++m)
#pragma unroll
                for (int n = 0; n < 2; ++n) acc[a][b][m][n] = (f32x4){0.f, 0.f, 0.f, 0.f};
    bf16x8 At[4][2], B0[2][2], B1[2][2];
    const char* cA = (const char*)g.A + S.offA(cur); const char* cB = (const char*)g.Bt + S.offB(cur);
    if constexpr (SP2) {
        PG8_STAGE(PG8_SB(0, 0), cB, voffB); PG8_STAGE(PG8_SB(0, 1), cB + hstep, voffB); PG8_STAGE(PG8_SA(0, 0), cA, voffA); PG8_STAGE(PG8_SA(0, 1), cA + hstepA, voffA);
        if (wr == 1) PG8_BAR;
        PG8_WAIT_V(2); PG8_BAR;
        PG8_STAGE(PG8_SB(1, 0), cB + kstep, voffB); PG8_STAGE(PG8_SA(1, 0), cA + kstepA, voffA); PG8_STAGE(PG8_SB(1, 1), cB + hstep + kstep, voffB);
        PG8_WAIT_V(6); PG8_BAR;
    } else {
        PG8_STAGE(PG8_SB(0, 0), cB, voffB); PG8_STAGE(PG8_SA(0, 0), cA, voffA); PG8_STAGE(PG8_SB(0, 1), cB + hstep, voffB); PG8_STAGE(PG8_SA(0, 1), cA + hstepA, voffA);
        if (wr == 1) PG8_BAR;
        PG8_WAIT_V(4); PG8_BAR;
        PG8_STAGE(PG8_SB(1, 0), cB + kstep, voffB); PG8_STAGE(PG8_SA(1, 0), cA + kstepA, voffA); PG8_STAGE(PG8_SB(1, 1), cB + hstep + kstep, voffB);
        PG8_WAIT_V(6); PG8_BAR;
    }
    for (;;) {
        const bool has_next = S.next(ui + 1, nxt);
        const char* nA = has_next ? (const char*)g.A + S.offA(nxt) : cA; const char* nB = has_next ? (const char*)g.Bt + S.offB(nxt) : cB;
        for (int t = 0; t < nt; t += 2) {
            if constexpr (Epi::HOOK) { if (t == 8 || t == 16) { int fr_ = fr, fq_ = fq; asm volatile("" : "+v"(fr_), "+v"(fq_)); E.hook(acc, cur, t, wr, wc, fr_, fq_); } }
            const bool last = (t == nt - 2);
            const char* a1 = cA + (size_t)(t + 1) * kstepA;
            const char* a2 = last ? nA : cA + (size_t)(t + 2) * kstepA; const char* b2 = last ? nB : cB + (size_t)(t + 2) * kstep;
            const char* a3 = a2 + kstepA; const char* b3 = b2 + kstep;
            if constexpr (SP2) {
            PG8_LDB(B0, 0, 0); PG8_LDB(B1, 0, 1); PG8_SCHED; PG8_LDA(At, 0, 0); PG8_STAGE(PG8_SA(1, 1), a1 + hstepA, voffA);
            PG8_WAIT_V(8); PG8_WAIT_L(0); PG8_BAR; PG8_MMA(0, 0, At, B0); PG8_MMA(0, 1, At, B1); PG8_BAR; PG8_SCHED;
            PG8_LDA(At, 0, 1); PG8_STAGE(PG8_SB(0, 0), b2, voffB); PG8_STAGE(PG8_SB(0, 1), b2 + hstep, voffB); PG8_STAGE(PG8_SA(0, 0), a2, voffA);
            PG8_WAIT_V(8); PG8_WAIT_L(0); PG8_BAR; PG8_MMA(1, 0, At, B0); PG8_MMA(1, 1, At, B1); PG8_BAR; PG8_SCHED;
            PG8_LDB(B0, 1, 0); PG8_LDB(B1, 1, 1); PG8_SCHED; PG8_LDA(At, 1, 0); PG8_STAGE(PG8_SA(0, 1), a2 + hstepA, voffA);
            PG8_WAIT_V(8); PG8_WAIT_L(0); PG8_BAR; PG8_MMA(0, 0, At, B0); PG8_MMA(0, 1, At, B1); PG8_BAR; PG8_SCHED;
            PG8_LDA(At, 1, 1); PG8_STAGE(PG8_SB(1, 0), b3, voffB); PG8_STAGE(PG8_SB(1, 1), b3 + hstep, voffB); PG8_STAGE(PG8_SA(1, 0), a3, voffA);
            PG8_WAIT_V(8); PG8_WAIT_L(0); PG8_BAR; PG8_MMA(1, 0, At, B0); PG8_MMA(1, 1, At, B1); PG8_BAR; PG8_SCHED;
            } else {
            PG8_LDB(B0, 0, 0); PG8_SCHED; PG8_LDA(At, 0, 0); PG8_STAGE(PG8_SA(1, 1), a1 + hstepA, voffA);
            PG8_WAIT_L(8); PG8_BAR; PG8_WAIT_L(0); PG8_MMA(0, 0, At, B0); PG8_BAR; PG8_SCHED;
            PG8_LDB(B1, 0, 1); PG8_STAGE(PG8_SB(0, 0), b2, voffB);
            PG8_BAR; PG8_WAIT_L(0); PG8_MMA(0, 1, At, B1); PG8_BAR;
            PG8_LDA(At, 0, 1); PG8_STAGE(PG8_SA(0, 0), a2, voffA);
            PG8_BAR; PG8_WAIT_L(0); PG8_MMA(1, 0, At, B0); PG8_BAR; PG8_SCHED;
            PG8_STAGE(PG8_SB(0, 1), b2 + hstep, voffB);
            PG8_WAIT_V(6); PG8_BAR; PG8_MMA(1, 1, At, B1); PG8_BAR;
            PG8_LDB(B0, 1, 0); PG8_SCHED; PG8_LDA(At, 1, 0); PG8_STAGE(PG8_SA(0, 1), a2 + hstepA, voffA);
            PG8_WAIT_L(8); PG8_BAR; PG8_WAIT_L(0); PG8_MMA(0, 0, At, B0); PG8_BAR; PG8_SCHED;
            PG8_LDB(B1, 1, 1); PG8_STAGE(PG8_SB(1, 0), b3, voffB);
            PG8_BAR; PG8_WAIT_L(0); PG8_MMA(0, 1, At, B1); PG8_BAR;
            PG8_LDA(At, 1, 1); PG8_STAGE(PG8_SA(1, 0), a3, voffA);
            PG8_BAR; PG8_WAIT_L(0); PG8_MMA(1, 0, At, B0); PG8_BAR; PG8_SCHED;
            PG8_STAGE(PG8_SB(1, 1), b3 + hstep, voffB);
            PG8_WAIT_V(6); PG8_BAR; PG8_MMA(1, 1, At, B1); PG8_BAR;
            }
        }
        f32x4 preq[8]; if constexpr (Epi::PRE) { int fr_ = fr; asm volatile("" : "+v"(fr_)); E.prefetch(preq, cur, wr, fr_); }
        if constexpr (ALIGN_EPI) { if (wr == 0) PG8_BAR; }
        { int fr_ = fr, fq_ = fq; asm volatile("" : "+v"(fr_), "+v"(fq_)); if constexpr (Epi::PRE) E.run(acc, preq, cur, wr, wc, fr_, fq_); else E(acc, cur, wr, wc, fr_, fq_); }
        if (!has_next) break;
#pragma unroll
        for (int a = 0; a < 2; ++a)
#pragma unroll
            for (int b = 0; b < 2; ++b)
#pragma unroll
                for (int m = 0; m < 4; ++m)
#pragma unroll
                    for (int n = 0; n < 2; ++n) acc[a][b][m][n] = (f32x4){0.f, 0.f, 0.f, 0.f};
        cur = nxt; cA = nA; cB = nB; ++ui;
        if constexpr (ALIGN_EPI) { if (wr == 1) PG8_BAR; }
    }
    PG8_WAIT_V(0);
    if constexpr (!ALIGN_EPI) { if (wr == 0) PG8_BAR; }
    PG8_BAR;
#undef PG8_SA
#undef PG8_SB
#undef PG8_STAGE
#undef PG8_LDA
#undef PG8_LDB
#undef PG8_MMA
#undef PG8_WAIT_V
#undef PG8_WAIT_L
#undef PG8_BAR
#undef PG8_SCHED
}
}

#include <hip/hip_bf16.h>
#include <cmath>
namespace attn_body {
using bf16=__hip_bfloat16;
using bf16x8=__attribute__((ext_vector_type(8)))short;
using s16x4=__attribute__((ext_vector_type(4)))short;
using f32x16=__attribute__((ext_vector_type(16)))float;
using u32x4=__attribute__((ext_vector_type(4)))unsigned;
constexpr int BATCH=2,NHEAD=16,SEQ=8192,D=64,DM=NHEAD*D, QP=64,KP=64,VP=128,OP=1024;
constexpr int NW=8,QBLK=32,QB=QBLK*NW,KVBLK=64,NQB=SEQ/QB;
constexpr int ATTN_PITCH=DM, ATTN_UNIT_ROWS=QB;
__device__ __forceinline__ int crow(int r,int hi){return (r&3)+8*(r>>2)+4*hi;}
#define SBAR() __builtin_amdgcn_sched_barrier(0)
__device__ __forceinline__ void cmask(f32x16&p0,f32x16&p1,int jb,int qrel,int hi){
  const float NEG=-INFINITY; int kb=64*jb+4*hi;
  #pragma unroll
  for(int r=0;r<16;++r){int kv=kb+(r&3)+8*(r>>2); if(kv>qrel)p0[r]=NEG; if(kv+32>qrel)p1[r]=NEG;}
}

constexpr int NSLOT=3, SLOTB=8192;
constexpr int LDS_K=0, LDS_V=NSLOT*SLOTB, LDS_WS=2*NSLOT*SLOTB, LDS_OST=LDS_WS+NW*64*4, LDS_BYTES=LDS_OST+NW*4096;
constexpr float C2=0.125f*1.4426950408889634f;
__device__ __forceinline__ void glds16(const void*gsrc,unsigned lds_dst){unsigned keep;
  asm volatile("s_mov_b32 %0, m0\n\ts_mov_b32 m0, %2\n\ts_nop 0\n\tglobal_load_lds_dwordx4 %1, off\n\ts_mov_b32 m0, %0":"=&s"(keep):"v"(gsrc),"s"(lds_dst):"memory");}
__device__ __forceinline__ float max3f(float a,float b,float c){float r;asm("v_max3_f32 %0, %1, %2, %3":"=v"(r):"v"(a),"v"(b),"v"(c));return r;}
__device__ __forceinline__ float max2f(float a,float b){float r;asm("v_max_f32_e32 %0, %1, %2":"=v"(r):"v"(a),"v"(b));return r;}
__device__ __forceinline__ float fadd_s(float a,float b){float r;asm("v_add_f32_e32 %0, %1, %2":"=v"(r):"v"(a),"v"(b));return r;}
__device__ __forceinline__ float fsub_s(float a,float b){float r;asm("v_sub_f32_e32 %0, %1, %2":"=v"(r):"v"(a),"v"(b));return r;}
typedef float f32x2_t __attribute__((ext_vector_type(2))); typedef __bf16 bf16x2_t __attribute__((ext_vector_type(2)));
__device__ __forceinline__ unsigned cvtpk_s(float lo,float hi){f32x2_t v={lo,hi};bf16x2_t b=__builtin_convertvector(v,bf16x2_t);return __builtin_bit_cast(unsigned,b);}
#define WAIT_BAR(N) asm volatile("s_waitcnt vmcnt(" #N ") lgkmcnt(0)\n\ts_barrier":::"memory")

__device__ __forceinline__ void qkt(f32x16&p0,f32x16&p1,const char*Kslot,const bf16x8*qr,const f32x16&negm,int r32,int hi){
  const char*kb=Kslot+hi*1024+r32*16;
  #pragma unroll
  for(int d0=0;d0<4;++d0){
    const bf16x8 b0=*reinterpret_cast<const bf16x8*>(kb+d0*2048);
    const bf16x8 b1=*reinterpret_cast<const bf16x8*>(kb+d0*2048+512);
    if(d0==0){p0=__builtin_amdgcn_mfma_f32_32x32x16_bf16(b0,qr[0],negm,0,0,0);p1=__builtin_amdgcn_mfma_f32_32x32x16_bf16(b1,qr[0],negm,0,0,0);}
    else{p0=__builtin_amdgcn_mfma_f32_32x32x16_bf16(b0,qr[d0],p0,0,0,0);p1=__builtin_amdgcn_mfma_f32_32x32x16_bf16(b1,qr[d0],p1,0,0,0);}}
}
typedef __attribute__((address_space(3))) const char* lds_cptr;
typedef short v4i16_t __attribute__((ext_vector_type(4)));
__device__ __forceinline__ void kload8(bf16x8*kf,lds_cptr kp){
  kf[0]=*(const __attribute__((address_space(3))) bf16x8*)(kp);      kf[1]=*(const __attribute__((address_space(3))) bf16x8*)(kp+512);
  kf[2]=*(const __attribute__((address_space(3))) bf16x8*)(kp+2048); kf[3]=*(const __attribute__((address_space(3))) bf16x8*)(kp+2560);
  kf[4]=*(const __attribute__((address_space(3))) bf16x8*)(kp+4096); kf[5]=*(const __attribute__((address_space(3))) bf16x8*)(kp+4608);
  kf[6]=*(const __attribute__((address_space(3))) bf16x8*)(kp+6144); kf[7]=*(const __attribute__((address_space(3))) bf16x8*)(kp+6656);
}
__device__ __forceinline__ void kload2(bf16x8*kf,lds_cptr kp,int j){ kf[2*j]=*(const __attribute__((address_space(3))) bf16x8*)(kp+j*2048); kf[2*j+1]=*(const __attribute__((address_space(3))) bf16x8*)(kp+j*2048+512); }
__device__ __forceinline__ s16x4 vtr(lds_cptr p){ return __builtin_bit_cast(s16x4,__builtin_amdgcn_ds_read_tr16_b64_v4i16((__attribute__((address_space(3))) v4i16_t*)p)); }
__device__ __forceinline__ float rowmax(const f32x16&p0,const f32x16&p1){
  float a=max3f(p0[0],p0[1],p1[0]),b=max3f(p0[2],p0[3],p1[1]);a=max3f(a,p1[2],p1[3]);
  #pragma unroll
  for(int r=4;r<16;r+=4){a=max3f(a,p0[r],p0[r+1]);b=max3f(b,p0[r+2],p0[r+3]);a=max3f(a,p1[r],p1[r+1]);b=max3f(b,p1[r+2],p1[r+3]);}
  const float m=max2f(a,b);
  auto rr=__builtin_amdgcn_permlane32_swap(__float_as_uint(m),__float_as_uint(m),false,false);
  return max2f(__uint_as_float(rr[0]),__uint_as_float(rr[1]));
}
__device__ __forceinline__ void pv(f32x16*o,int vb,bf16x8 pa0,bf16x8 pa1,bf16x8 pa2,bf16x8 pa3){
  #pragma unroll
  for(int d0=0;d0<2;++d0){s16x4 lo[4],hi[4];
    #pragma unroll
    for(int ks=0;ks<4;++ks){
      asm volatile("ds_read_b64_tr_b16 %0,%1 offset:%c2":"=&v"(lo[ks]):"v"(vb),"i"(d0*4096+ks*1024):"memory");
      asm volatile("ds_read_b64_tr_b16 %0,%1 offset:%c2":"=&v"(hi[ks]):"v"(vb),"i"(d0*4096+ks*1024+512):"memory");}
    asm volatile("s_waitcnt lgkmcnt(0)":::"memory");SBAR();
    #define PK(k) (bf16x8){lo[k][0],lo[k][1],lo[k][2],lo[k][3],hi[k][0],hi[k][1],hi[k][2],hi[k][3]}
    o[d0]=__builtin_amdgcn_mfma_f32_32x32x16_bf16(pa0,PK(0),o[d0],0,0,0);
    o[d0]=__builtin_amdgcn_mfma_f32_32x32x16_bf16(pa1,PK(1),o[d0],0,0,0);
    o[d0]=__builtin_amdgcn_mfma_f32_32x32x16_bf16(pa2,PK(2),o[d0],0,0,0);
    o[d0]=__builtin_amdgcn_mfma_f32_32x32x16_bf16(pa3,PK(3),o[d0],0,0,0);
    #undef PK
  }
}

#ifndef ATTN_STORE16
#define ATTN_STORE16(p,v) (*(u32x4*)(p)=(v))
#endif
template<int THRL> __device__ __forceinline__ void attn_unit(int b,int h,int qb,const bf16*Q,const bf16*__restrict__ K,const bf16*__restrict__ V,bf16*O,char*shm){
  int tid_=threadIdx.x; asm volatile("":"+v"(tid_)); const int tid=tid_,lane=tid&63,r32=lane&31,hi=lane>>5; const int wid=__builtin_amdgcn_readfirstlane(tid>>6);
  const long rowbase=(long)b*SEQ; const int q0=qb*QB;
  const bf16*Qw=Q+((long)(h>>1)*(BATCH*SEQ)+rowbase+q0+wid*QBLK)*QP;
  const bf16*Kh=K+((long)(h>>1)*(BATCH*SEQ)+rowbase)*KP,*Vh=V+((long)(h>>2)*(BATCH*SEQ)+rowbase)*VP+(h&1)*64;
  const unsigned lds0=(unsigned)(uintptr_t)shm;
  float*wsf=(float*)(shm+LDS_WS)+wid*64;
  const bf16*ksrc=Kh+(long)lane*KP+wid*8;
  const bf16*vsrc=Vh+(long)(16*(wid&3)+(lane>>2))*VP+(wid>>2)*32+(lane&3)*8;
  const unsigned kdst=lds0+LDS_K+wid*1024, vdst=lds0+LDS_V+wid*1024;
  #define DMA_K(t,slot) glds16(ksrc+(long)(t)*KVBLK*KP,(unsigned)__builtin_amdgcn_readfirstlane(kdst+(slot)))
  #define DMA_V(t,slot) glds16(vsrc+(long)(t)*KVBLK*VP,(unsigned)__builtin_amdgcn_readfirstlane(vdst+(slot)))
  const int vb0=(int)(lds0+LDS_V)+((lane>>4)&1)*32+(lane&3)*8+(4*hi+((lane&15)>>2))*64;
  const char*Kbase=shm+LDS_K; bf16x8 kf[8];
  const lds_cptr shm3=(lds_cptr)shm; const lds_cptr kp0=shm3+LDS_K+hi*1024+r32*16; const lds_cptr vp0=shm3+LDS_V+((lane>>4)&1)*32+(lane&3)*8+(4*hi+((lane&15)>>2))*64;
  const int NT=(q0+QB)/KVBLK;
  DMA_K(0,0);DMA_V(0,0);DMA_K(1,SLOTB);
  bf16x8 qr[4];
  #pragma unroll
  for(int d0=0;d0<4;++d0)qr[d0]=*reinterpret_cast<const bf16x8*>(&Qw[(long)r32*QP+d0*16+hi*8]);
  float mhat=0.f,l_reg=0.f;f32x16 o[2];o[0]=f32x16{};o[1]=f32x16{};f32x16 negm=f32x16{};asm volatile("":"+v"(negm));
  const int qrel=wid*QBLK+r32;
  #define CMASK(P0,P1,t) do{int jb_=(t)-(NT-4); if(jb_>=0)cmask(P0,P1,jb_,qrel,hi);}while(0)
  bool resc=false;
  #define START(P0,P1) do{ const float rm=rowmax(P0,P1); resc=false; \
    { const float dl=rm; mhat=fadd_s(mhat,dl); \
      _Pragma("unroll") for(int r=0;r<16;++r){P0[r]=fsub_s(P0[r],dl);P1[r]=fsub_s(P1[r],dl);} \
      _Pragma("unroll") for(int r=0;r<16;++r)negm[r]=-mhat; asm volatile("":"+v"(negm)); } \
    _Pragma("unroll") for(int r=0;r<16;++r)P0[r]=__builtin_amdgcn_exp2f(P0[r]); }while(0)
  #define RESC() do{ if(resc){ asm volatile("s_waitcnt lgkmcnt(0)":::"memory"); \
      _Pragma("unroll") for(int d_=0;d_<2;++d_) _Pragma("unroll") for(int r=0;r<16;++r)o[d_][r]*=wsf[crow(r,hi)]; } }while(0)
  f32x16 pA0,pA1,pB0,pB1;
  int sl_prev=0,sl_cur=0,sl_next=SLOTB;
  #define ROT() do{sl_prev=sl_cur;sl_cur=sl_next;sl_next=(sl_next==(NSLOT-1)*SLOTB)?0:sl_next+SLOTB;}while(0)
  DMA_K(2,2*SLOTB);
  WAIT_BAR(3);
  qkt(pA0,pA1,Kbase,qr,negm,r32,hi);asm volatile("s_nop 15\n\ts_nop 7":"+v"(pA0),"+v"(pA1));CMASK(pA0,pA1,0);
  START(pA0,pA1);
  _Pragma("unroll") for(int r=0;r<16;++r)pA1[r]=__builtin_amdgcn_exp2f(pA1[r]);
  WAIT_BAR(0);
  DMA_K(3,0);DMA_V(1,SLOTB);
  ROT();
  kload8(kf,kp0+sl_cur);
  WAIT_BAR(2);
  s16x4 vlo[8],vhi[8]; u32x4 pw0,pw1,pw2,pw3;
  #define PKW(P,B) cvtpk_s(P[B],P[B+1])
  #define PAF(k) __builtin_bit_cast(bf16x8,pw##k)
  #define VFR(i) (bf16x8){vlo[i][0],vlo[i][1],vlo[i][2],vlo[i][3],vhi[i][0],vhi[i][1],vhi[i][2],vhi[i][3]}
  #define PIN(x) asm volatile("":"+v"(x))
  #define MX3(a,b,c) __builtin_fmaxf(__builtin_fmaxf((a),(b)),(c))
  #define GAPA(MF,A0,A1,A2,A3,W0,W1,PW) do{ MF; sacc+=A0; sacc+=A1; sacc+=A2; sacc+=A3; PIN(sacc); W0; W1; PIN(PW); SBAR(); }while(0)
  #define EX(v) __builtin_amdgcn_exp2f(v)
  #define GAPB(MF,X,B) do{ MF; X[B]=EX(X[B]); X[B+1]=EX(X[B+1]); X[B+2]=EX(X[B+2]); X[B+3]=EX(X[B+3]); PIN(X); SBAR(); }while(0)
  #define VRD(i) do{ vlo[i]=vtr(vp_+(((i)>>2)*4096+((i)&3)*1024)); vhi[i]=vtr(vp_+(((i)>>2)*4096+((i)&3)*1024+512)); }while(0)
  #define KRD(G,j) do{ if(G){ kload2(kf,kp0+sl_next,j); SBAR(); } }while(0)
  #define STEP(C0,C1,P0,P1,t,GK,GV,GL) do{ SBAR(); \
    const lds_cptr vp_=vp0+sl_prev; \
    VRD(0); SBAR(); float sacc=(P0[0]+P0[1]); \
    GAPA(C0=__builtin_amdgcn_mfma_f32_32x32x16_bf16(kf[0],qr[0],negm,0,0,0), P0[2],P0[3],P0[4],P0[5],     pw0[0]=PKW(P0,0), pw0[1]=PKW(P0,2), pw0); \
    VRD(4); SBAR(); GAPA(C1=__builtin_amdgcn_mfma_f32_32x32x16_bf16(kf[1],qr[0],negm,0,0,0), P0[6],P0[7],P0[8],P0[9],     pw0[2]=PKW(P0,4), pw0[3]=PKW(P0,6), pw0); \
    VRD(1); SBAR(); GAPA(C0=__builtin_amdgcn_mfma_f32_32x32x16_bf16(kf[2],qr[1],C0,0,0,0),   P0[10],P0[11],P0[12],P0[13], pw1[0]=PKW(P0,8), pw1[1]=PKW(P0,10), pw1); \
    VRD(5); SBAR(); GAPA(C1=__builtin_amdgcn_mfma_f32_32x32x16_bf16(kf[3],qr[1],C1,0,0,0),   P0[14],P0[15],P1[0],P1[1],   pw1[2]=PKW(P0,12),pw1[3]=PKW(P0,14), pw1); \
    VRD(2); SBAR(); GAPA(C0=__builtin_amdgcn_mfma_f32_32x32x16_bf16(kf[4],qr[2],C0,0,0,0),   P1[2],P1[3],P1[4],P1[5],     pw2[0]=PKW(P1,0), pw2[1]=PKW(P1,2), pw2); \
    VRD(6); SBAR(); GAPA(C1=__builtin_amdgcn_mfma_f32_32x32x16_bf16(kf[5],qr[2],C1,0,0,0),   P1[6],P1[7],P1[8],P1[9],     pw2[2]=PKW(P1,4), pw2[3]=PKW(P1,6), pw2); \
    VRD(3); SBAR(); GAPA(C0=__builtin_amdgcn_mfma_f32_32x32x16_bf16(kf[6],qr[3],C0,0,0,0),   P1[10],P1[11],P1[12],P1[13], pw3[0]=PKW(P1,8), pw3[1]=PKW(P1,10), pw3); \
    VRD(7); SBAR(); GAPA(C1=__builtin_amdgcn_mfma_f32_32x32x16_bf16(kf[7],qr[3],C1,0,0,0),   P1[14],P1[15],0.f,0.f,       pw3[2]=PKW(P1,12),pw3[3]=PKW(P1,14), pw3); \
    l_reg+=sacc; \
    if(GK){DMA_K((t)+3,sl_cur);} if(GV){DMA_V((t)+1,sl_next);} \
    CMASK(C0,C1,t); \
    { float a=MX3(C0[0],C0[1],C1[0]),b=MX3(C0[2],C0[3],C1[1]); a=MX3(a,C1[2],C1[3]); \
      _Pragma("unroll") for(int r=4;r<16;r+=4){a=MX3(a,C0[r],C0[r+1]);b=MX3(b,C0[r+2],C0[r+3]);a=MX3(a,C1[r],C1[r+1]);b=MX3(b,C1[r+2],C1[r+3]);} \
      float rm=__builtin_fmaxf(a,b); { auto rr=__builtin_amdgcn_permlane32_swap(__float_as_uint(rm),__float_as_uint(rm),false,false); rm=__builtin_fmaxf(__uint_as_float(rr[0]),__uint_as_float(rr[1])); } \
      resc=false; \
      if(__builtin_expect(__any(rm>(float)THRL),0)){ const float dl=__builtin_fmaxf(rm,0.f); mhat+=dl; \
        _Pragma("unroll") for(int r=0;r<16;++r){C0[r]-=dl;C1[r]-=dl;} \
        _Pragma("unroll") for(int r=0;r<16;++r)negm[r]=-mhat; asm volatile("":"+v"(negm)); \
        const float f=__builtin_amdgcn_exp2f(-dl); l_reg*=f; if(hi==0)wsf[r32]=f; resc=true; } } \
    SBAR(); \
    GAPB(o[0]=__builtin_amdgcn_mfma_f32_32x32x16_bf16(PAF(0),VFR(0),o[0],0,0,0), C0,0); \
    GAPB(o[1]=__builtin_amdgcn_mfma_f32_32x32x16_bf16(PAF(0),VFR(4),o[1],0,0,0), C0,4); \
    KRD(GL,0); GAPB(o[0]=__builtin_amdgcn_mfma_f32_32x32x16_bf16(PAF(1),VFR(1),o[0],0,0,0), C0,8); \
    KRD(GL,1); GAPB(o[1]=__builtin_amdgcn_mfma_f32_32x32x16_bf16(PAF(1),VFR(5),o[1],0,0,0), C0,12); \
    KRD(GL,2); GAPB(o[0]=__builtin_amdgcn_mfma_f32_32x32x16_bf16(PAF(2),VFR(2),o[0],0,0,0), C1,0); \
    KRD(GL,3); GAPB(o[1]=__builtin_amdgcn_mfma_f32_32x32x16_bf16(PAF(2),VFR(6),o[1],0,0,0), C1,4); \
    GAPB(o[0]=__builtin_amdgcn_mfma_f32_32x32x16_bf16(PAF(3),VFR(3),o[0],0,0,0), C1,8); \
    GAPB(o[1]=__builtin_amdgcn_mfma_f32_32x32x16_bf16(PAF(3),VFR(7),o[1],0,0,0), C1,12); \
    }while(0)
  int t=1;
  #undef CMASK
  #define CMASK(P0,P1,t) do{}while(0)
  for(;t+5<NT;t+=2){
    STEP(pB0,pB1,pA0,pA1,t,true,true,true);     WAIT_BAR(2); RESC(); ROT();
    STEP(pA0,pA1,pB0,pB1,t+1,true,true,true);   WAIT_BAR(2); RESC(); ROT();
  }
  #undef CMASK
  #define CMASK(P0,P1,t) do{int jb_=(t)-(NT-4); if(jb_>=0)cmask(P0,P1,jb_,qrel,hi);}while(0)
  #define ENDW(tt) do{ if((tt)+3<NT){WAIT_BAR(2);} else if((tt)+2<NT){WAIT_BAR(1);} else {WAIT_BAR(0);} }while(0)
  for(;t+1<NT;t+=2){
    STEP(pB0,pB1,pA0,pA1,t,(t+3<NT),(t+1<NT),(t+1<NT));       ENDW(t);   RESC(); ROT();
    STEP(pA0,pA1,pB0,pB1,t+1,(t+4<NT),(t+2<NT),(t+2<NT));     ENDW(t+1); RESC(); ROT();
  }
  STEP(pB0,pB1,pA0,pA1,NT-1,false,false,false); RESC();
  { float sacc=pB0[0]+pB0[1]; _Pragma("unroll") for(int r=2;r<16;++r)sacc+=pB0[r]; _Pragma("unroll") for(int r=0;r<16;++r)sacc+=pB1[r]; l_reg+=sacc;
    pw0=(u32x4){PKW(pB0,0),PKW(pB0,2),PKW(pB0,4),PKW(pB0,6)};pw1=(u32x4){PKW(pB0,8),PKW(pB0,10),PKW(pB0,12),PKW(pB0,14)};pw2=(u32x4){PKW(pB1,0),PKW(pB1,2),PKW(pB1,4),PKW(pB1,6)};pw3=(u32x4){PKW(pB1,8),PKW(pB1,10),PKW(pB1,12),PKW(pB1,14)};
    SBAR(); pv(o,vb0+sl_cur,PAF(0),PAF(1),PAF(2),PAF(3)); }
  #undef PKW
  #undef PAF
  #undef VFR
  #undef PIN
  #undef MX3
  #undef GAPA
  #undef GAPB
  #undef EX
  #undef VRD
  #undef KRD
  #undef STEP
  #undef ENDW
  {auto rr=__builtin_amdgcn_permlane32_swap(__float_as_uint(l_reg),__float_as_uint(l_reg),false,false);l_reg=__uint_as_float(rr[0])+__uint_as_float(rr[1]);}
  if(hi==0)wsf[32+r32]=l_reg;asm volatile("s_waitcnt lgkmcnt(0)":::"memory");
  float rli[16];
  #pragma unroll
  for(int r=0;r<16;++r)rli[r]=__builtin_amdgcn_rcpf(wsf[32+crow(r,hi)]);
  bf16*Ow=O+(rowbase+q0+wid*QBLK)*OP+h*D;
  { bf16*stg=(bf16*)(shm+LDS_OST)+wid*2048;
    #pragma unroll
    for(int r=0;r<16;++r){const int orow=crow(r,hi);
      #pragma unroll
      for(int d0=0;d0<2;++d0)stg[orow*64+d0*32+r32]=__float2bfloat16(o[d0][r]*rli[r]);}
    asm volatile("s_waitcnt lgkmcnt(0)":::"memory");
    #pragma unroll
    for(int i=0;i<4;++i){const int row=i*8+(lane>>3),ch=lane&7; const u32x4 v=*(const u32x4*)(stg+row*64+ch*8); ATTN_STORE16(Ow+(long)row*OP+ch*8,v);} }
  asm volatile("s_waitcnt lgkmcnt(0)\n\ts_barrier":::"memory");
  #undef DMA_K
  #undef DMA_V
  #undef CMASK
  #undef START
  #undef RESC
  #undef ROT
}
constexpr int ATTN_LDS_BYTES=LDS_BYTES;
struct AttnTensors { const bf16* Q; const bf16* K; const bf16* V; bf16* O; };
struct AttnUnit { int bh; int qb; };
struct StaticOrder {
  int vcu;
  __device__ __forceinline__ explicit StaticOrder(int grid,int block):vcu((block%8)*(grid/8)+block/8){}
  __device__ __forceinline__ bool next(int i,AttnUnit&u)const{ if(i>=4)return false; const int s=vcu&7; u.bh=vcu>>3; u.qb=(i==0)?s:(i==1)?15-s:(i==2)?16+s:31-s; return true; }
  __device__ __forceinline__ void a_ready(const AttnUnit&)const{}
  __device__ __forceinline__ void done(const AttnUnit&)const{}
};
template<class Sched,int THRL=8> __device__ __forceinline__ void attn_phase(char*lds,const AttnTensors&T,const Sched&S){
  AttnUnit u;
  for(int i=0;S.next(i,u);++i){ S.a_ready(u); attn_unit<THRL>(u.bh/NHEAD,u.bh%NHEAD,u.qb,T.Q,T.K,T.V,T.O,lds); S.done(u); }
}
#undef SBAR
#undef WAIT_BAR
}


namespace cg = cooperative_groups;
#define LAS __attribute__((address_space(3)))
typedef unsigned short bf16;
typedef float f32x4 __attribute__((ext_vector_type(4)));
typedef unsigned u32x4 __attribute__((ext_vector_type(4)));
typedef unsigned u32x2 __attribute__((ext_vector_type(2)));
typedef short bf16x8 __attribute__((ext_vector_type(8)));
using pg8::cvt_pk_bf16; using pg8::bflo; using pg8::bfhi; using pg8::pack8; using pg8::unpack8;

constexpr int SEQ = 8192, M = 16384, DMODEL = 1024, DEPTH = 4, INC = 9728, DFF = 2816, NWAVES = 8;
#ifndef ATTREP
#define ATTREP 0
#endif
#ifndef CONVREP
#define CONVREP 0
#endif
#ifndef DILREP
#define DILREP 0
#endif
#ifndef USE_XBAR
#define USE_XBAR 1
#endif
#ifndef SEAM_FENCES
#define SEAM_FENCES 0
#endif
#ifndef XSEAM
#define XSEAM 0
#endif
#ifndef RPT
#define RPT 0
#endif
#ifndef PHMASK
#define PHMASK 0xBEF
#endif
constexpr int NPH = 12;
constexpr size_t MiB = 1u << 20;
constexpr size_t WS_WIN = 0, WS_WBRA = 19 * MiB, WS_WBRB = 20 * MiB, WS_WBRC = 21 * MiB, WS_WGLU = 22 * MiB, WS_WOUT = 23 * MiB, WS_WUP = 25 * MiB, WS_WDOWN = 36 * MiB,
                 WS_WS1 = 42 * MiB, WS_WS2 = 66 * MiB, WS_L32 = 70 * MiB, WS_ROPEA = 71 * MiB, WS_ROPEB = 72 * MiB, WS_X = 74 * MiB, WS_H = 138 * MiB,
                 WS_QA = 170 * MiB, WS_KA = 186 * MiB, WS_VA = 202 * MiB, WS_QB = 218 * MiB, WS_KB = 266 * MiB, WS_VB = 314 * MiB, WS_CU = 362 * MiB, WS_GATES = 378 * MiB,
                 WS_OG = 474 * MiB, WS_LSE = 522 * MiB, WS_OA = 523 * MiB, WS_Y = 539 * MiB, WS_E = 571 * MiB, WS_CARRY = 579 * MiB, WS_END = 583 * MiB;
constexpr size_t WS_O16 = WS_H, WS_Z = WS_QA, WS_OC = WS_KA, WS_OB = WS_VA, WS_MF = WS_QB, WS_MB = WS_VB;
constexpr size_t WS_FA = 170 * MiB, WS_FB = 258 * MiB, WS_ACT = 346 * MiB;
constexpr int LDS_BYTES = 147456, XCH_OFF = 131072, XBST_OFF = 139264;
constexpr size_t WS_CTL = WS_END, CTL_BYTES = 16384, WS_SSQ = WS_END + MiB, WS_TOTAL = WS_END + 2 * MiB;

struct Args { const void* in[33]; float* out; unsigned char* ws; int ph_lo, ph_hi; };

using pg8::shx;
__device__ __forceinline__ float wave_sum(float v, int lane) {
#pragma unroll
    for (int o = 1; o < 64; o <<= 1) v += shx(v, o, lane);
    return v;
}
__device__ __forceinline__ int inproj_col(int n) {
    const int pn = n >> 8, p = n & 255, bj = p >> 7, wc = (p >> 5) & 3, fq = (p >> 3) & 3, j = p & 7;
    if (pn < 4) { const int d = bj ? 32 + 8 * fq + j : (j < 2 ? 2 * fq + j : (j < 4 ? 8 + 2 * fq + (j - 2) : 16 + 4 * fq + (j - 4))); return pn * 256 + wc * 64 + d; }
    if (pn >= 6 && pn < 18) { const int head = wc >> 1, w = wc & 1; const int d = w ? 64 + 32 * bj + 8 * fq + j : (bj ? 32 + 8 * fq + j : (j < 4 ? 4 * fq + j : 16 + 4 * fq + (j - 4))); return pn * 256 + head * 128 + d; }
    return n;
}
__device__ __forceinline__ int srccol(int mapid, int n) {
    if (mapid == 1) return inproj_col(n);
    if (mapid == 2) { const int pn = n >> 8, p = n & 255; return (p >> 7) * DFF + pn * 128 + (p & 127); }
    return n;
}
__device__ __forceinline__ void transpose_item(const float* W, int K, int N, bf16* WT, int mapid, LAS float* scr, int item, int lane, int ldw = 0, int koff = 0) {
    if (ldw == 0) ldw = K;
    const int nblk = N / 32, kb = item / nblk, nb = item % nblk, k0 = 64 * kb, n0 = 32 * nb;
    const int sc = srccol(mapid, n0 + (lane & 31));
    float tv[32];
#pragma unroll
    for (int i = 0; i < 32; ++i) tv[i] = W[(size_t)(k0 + 2 * i + (lane >> 5)) * N + sc];
#pragma unroll
    for (int i = 0; i < 32; ++i) scr[(2 * i + (lane >> 5)) * 33 + (lane & 31)] = tv[i];
    asm volatile("s_waitcnt lgkmcnt(0)" ::: "memory");
    const int c = lane & 7;
#pragma unroll
    for (int j = 0; j < 4; ++j) { const int n = (lane >> 3) + 8 * j; const LAS float* s = scr + (8 * c) * 33 + n;
        u32x4 o; o.x = cvt_pk_bf16(s[0 * 33], s[1 * 33]); o.y = cvt_pk_bf16(s[2 * 33], s[3 * 33]); o.z = cvt_pk_bf16(s[4 * 33], s[5 * 33]); o.w = cvt_pk_bf16(s[6 * 33], s[7 * 33]);
        *(u32x4*)(WT + (size_t)(n0 + n) * ldw + koff + k0 + 8 * c) = o; }
    asm volatile("s_waitcnt lgkmcnt(0)" ::: "memory");
}
__device__ __forceinline__ void rms_row(const float* xrow, const float* g, bf16* orow, float* ssq4, int lane) {
    const f32x4* xr = (const f32x4*)xrow + lane; const f32x4* gr = (const f32x4*)g + lane;
    f32x4 v[4]; float s = 0.f;
#pragma unroll
    for (int j = 0; j < 4; ++j) { v[j] = xr[64 * j]; s += (v[j].x * v[j].x + v[j].y * v[j].y) + (v[j].z * v[j].z + v[j].w * v[j].w); }
    const float tot = wave_sum(s, lane);
    if (lane < 4) ssq4[lane] = (lane == 0) ? tot : 0.f;
    u32x2* o8 = (u32x2*)orow + lane;
#pragma unroll
    for (int j = 0; j < 4; ++j) { const f32x4 gg = gr[64 * j]; u32x2 w; w.x = cvt_pk_bf16(v[j].x * gg.x, v[j].y * gg.y); w.y = cvt_pk_bf16(v[j].z * gg.z, v[j].w * gg.w); o8[64 * j] = w; }
}

#define XB_TMO      128
#define XB_XCNT(j)  (256  + 64 * (j))
#define XB_XSUB(j)  (1280 + 64 * (j))
#define XB_XGEN(j)  (2304 + 64 * (j))
#define XB_TOP      3328
#define XB_TOPGEN   3392
#define XCD_BAR_WORDS 3456
#define XB_SPIN_CAP (1u << 18)

__device__ __forceinline__ unsigned xb_ld(unsigned* p)              { return __hip_atomic_load(p, __ATOMIC_RELAXED, __HIP_MEMORY_SCOPE_AGENT); }
__device__ __forceinline__ unsigned xb_add(unsigned* p, unsigned v) { return __hip_atomic_fetch_add(p, v, __ATOMIC_RELAXED, __HIP_MEMORY_SCOPE_AGENT); }
__device__ __forceinline__ unsigned xb_xcc_id() { return (unsigned)__builtin_amdgcn_s_getreg((3 << 11) | 20) & 0xFu; }
#define XB_SPIN(cond, bar) do { unsigned _sp = 0; while (cond) { __builtin_amdgcn_s_sleep(1); \
    if ((++_sp & 255u) == 0u) { if (xb_ld(&(bar)[XB_TMO])) break; if (_sp > XB_SPIN_CAP) { atomicAdd(&(bar)[XB_TMO], 1u); break; } } } } while (0)

struct XcdBarrier {
    unsigned* bar; unsigned x;
    volatile LAS unsigned* st;
};

__device__ __forceinline__ XcdBarrier xcd_barrier_post(unsigned* bar, volatile LAS unsigned* st) {
    XcdBarrier b; b.bar = bar; b.x = xb_xcc_id(); b.st = st;
    if (threadIdx.x == 0) (void)xb_add(&bar[XB_XCNT(b.x)], 1u);
    return b;
}
__device__ __forceinline__ void xcd_barrier_complete(unsigned* bar, unsigned x, unsigned& nloc, unsigned& nx) {
    const unsigned G = gridDim.x * gridDim.y * gridDim.z;
    unsigned sum, cnt, mine, sp = 0u;
    for (;;) {
        sum = 0u; cnt = 0u; mine = 0u;
#pragma unroll
        for (unsigned j = 0; j < 16; ++j) { const unsigned c = xb_ld(&bar[XB_XCNT(j)]); sum += c; cnt += (c > 0u) ? 1u : 0u; mine = (j == x) ? c : mine; }
        if (sum == G) break;
        __builtin_amdgcn_s_sleep(1);
        if ((++sp & 255u) == 0u) { if (xb_ld(&bar[XB_TMO])) break; if (sp > XB_SPIN_CAP) { atomicAdd(&bar[XB_TMO], 1u); break; } }
    }
    nloc = mine > 0u ? mine : 1u; nx = cnt > 0u ? cnt : 1u;
}

__device__ __forceinline__ void xcd_barrier(const XcdBarrier& b) {
    asm volatile("s_waitcnt vmcnt(0)" ::: "memory");
    __syncthreads();
    if (threadIdx.x == 0) {
        unsigned* bar = b.bar;
        __builtin_amdgcn_s_waitcnt(0);
        unsigned nloc = b.st[0], nx = b.st[1];
        if (nloc == 0u) { xcd_barrier_complete(bar, b.x, nloc, nx); b.st[0] = nloc; b.st[1] = nx; }
        const unsigned old = xb_add(&bar[XB_XSUB(b.x)], 1u);
        const unsigned gen = old / nloc;
        if (old + 1u == (gen + 1u) * nloc) {
            __builtin_amdgcn_fence(__ATOMIC_RELEASE, "agent");
            asm volatile("s_waitcnt vmcnt(0)" ::: "memory");
            const unsigned og = xb_add(&bar[XB_TOP], 1u);
            const unsigned tg = og / nx;
            if (og + 1u == (tg + 1u) * nx) xb_add(&bar[XB_TOPGEN], 1u);
            else XB_SPIN(xb_ld(&bar[XB_TOPGEN]) == tg, bar);
            __builtin_amdgcn_fence(__ATOMIC_ACQUIRE, "agent");
            xb_add(&bar[XB_XGEN(b.x)], 1u);
            asm volatile("s_waitcnt vmcnt(0)" ::: "memory");
        } else {
            XB_SPIN(xb_ld(&bar[XB_XGEN(b.x)]) == gen, bar);
            __builtin_amdgcn_fence(__ATOMIC_ACQUIRE, "agent");
            asm volatile("s_waitcnt vmcnt(0)" ::: "memory");
        }
    }
    __syncthreads();
}

__device__ __forceinline__ void ssm_build(int g, const float* a_re, const float* a_im, const float* log_dt, const float* b_re, const float* b_im, const float* c_re, const float* c_im,
                                          bf16* W1, bf16* W2, float* L32, LAS float* sm, int tid, int half) {
    LAS float* pw_re = sm; LAS float* pw_im = sm + 2112; LAS float* bb_re = sm + 4224; LAS float* bb_im = sm + 5248; LAS float* cc_re = sm + 6272; LAS float* cc_im = sm + 7296; LAS float* kern = sm + 8320;
    const float dt = expf(log_dt[g]);
    for (int idx = tid; idx < 33 * 64; idx += 512) { const int tau = idx >> 6, p = idx & 63; const float are = a_re[g * 64 + p], aim = a_im[g * 64 + p];
        const float mag = expf(are * dt * (float)tau); float s, c; sincosf(aim * dt * (float)tau, &s, &c); pw_re[idx] = mag * c; pw_im[idx] = mag * s; }
    __syncthreads();
    for (int idx = tid; idx < 1024; idx += 512) { const int p = idx >> 4; const float are = a_re[g * 64 + p], aim = a_im[g * 64 + p];
        const float nre = pw_re[64 + p] - 1.0f, nim = pw_im[64 + p], den = are * are + aim * aim;
        const float fre = (nre * are + nim * aim) / den, fim = (nim * are - nre * aim) / den;
        const float br = b_re[(size_t)g * 1024 + idx], bi = b_im[(size_t)g * 1024 + idx];
        bb_re[idx] = fre * br - fim * bi; bb_im[idx] = fre * bi + fim * br;
        cc_re[idx] = c_re[(size_t)g * 1024 + idx]; cc_im[idx] = c_im[(size_t)g * 1024 + idx]; }
    __syncthreads();
    for (int idx = tid; idx < 8192; idx += 512) { const int tau = idx >> 8, c = (idx >> 4) & 15, c2 = idx & 15; float acc = 0.f;
        for (int p = 0; p < 64; ++p) { const float cr = cc_re[c * 64 + p], ci = cc_im[c * 64 + p], pr = pw_re[tau * 64 + p], pi = pw_im[tau * 64 + p];
            const float xr = cr * pr - ci * pi, xi = cr * pi + ci * pr; acc += xr * bb_re[p * 16 + c2] - xi * bb_im[p * 16 + c2]; }
        kern[idx] = acc; }
    __syncthreads();
    bf16* W1g = W1 + (size_t)g * 768 * 512; bf16* W2g = W2 + (size_t)g * 512 * 128;
    for (int idx = tid + half * (768 * 32); idx < (half + 1) * (768 * 32); idx += 512) { const int n = idx >> 6, q = idx & 63, s = q >> 1, c0 = (q & 1) * 8; float v[8];
        if (n < 512) { const int t = n >> 4, c = n & 15;
#pragma unroll
            for (int j = 0; j < 8; ++j) v[j] = (s <= t) ? kern[(t - s) * 256 + c * 16 + c0 + j] : 0.f; }
        else if (n < 640) { const int e = n - 512, p = e & 63; const float pr = pw_re[(31 - s) * 64 + p], pi = pw_im[(31 - s) * 64 + p];
#pragma unroll
            for (int j = 0; j < 8; ++j) { const float br = bb_re[p * 16 + c0 + j], bi = bb_im[p * 16 + c0 + j]; v[j] = (e < 64) ? (pr * br - pi * bi) : (pr * bi + pi * br); } }
        else {
#pragma unroll
            for (int j = 0; j < 8; ++j) v[j] = 0.f; }
        u32x4 o; o.x = cvt_pk_bf16(v[0], v[1]); o.y = cvt_pk_bf16(v[2], v[3]); o.z = cvt_pk_bf16(v[4], v[5]); o.w = cvt_pk_bf16(v[6], v[7]);
        *(u32x4*)(W1g + (size_t)n * 512 + q * 8) = o; }
    for (int idx = tid + half * 4096; idx < (half + 1) * 4096; idx += 512) { const int n = idx >> 4, q = idx & 15, t = n >> 4, c = n & 15; float v[8];
#pragma unroll
        for (int j = 0; j < 8; ++j) { const int k = q * 8 + j, p = k & 63; const float cr = cc_re[c * 64 + p], ci = cc_im[c * 64 + p], pr = pw_re[(t + 1) * 64 + p], pi = pw_im[(t + 1) * 64 + p];
            v[j] = (k < 64) ? (cr * pr - ci * pi) : -(cr * pi + ci * pr); }
        u32x4 o; o.x = cvt_pk_bf16(v[0], v[1]); o.y = cvt_pk_bf16(v[2], v[3]); o.z = cvt_pk_bf16(v[4], v[5]); o.w = cvt_pk_bf16(v[6], v[7]);
        *(u32x4*)(W2g + (size_t)n * 128 + q * 8) = o; }
    if (half == 0 && tid < 64) { L32[(g * 64 + tid) * 2] = pw_re[32 * 64 + tid]; L32[(g * 64 + tid) * 2 + 1] = pw_im[32 * 64 + tid]; }
    __syncthreads();
}

constexpr int KSTR = 272, VSTR = 528, DIL_VT_OFF = 256 * KSTR;
struct DilRegs { u32x4 k[8], v[8]; bf16x8 q[4]; };
__device__ __forceinline__ void dil_load(int it, const bf16* qb, const bf16* kb, const bf16* vb, DilRegs& R, int tid, int cont) {
    const int lane = tid & 63, w = __builtin_amdgcn_readfirstlane(tid >> 6), fr = lane & 15, fq = lane >> 4;
    const int b = it / 768; int r = it % 768; const int g = r >> 8; r &= 255; const int h = r >> 6, blk = r & 63;
    const int dl = 2 * g, dil = 1 << dl, res = blk & (dil - 1), n = blk >> dl;
    const size_t tokbase = (size_t)b * SEQ; const int colbase = g * 512 + h * 128;
#pragma unroll
    for (int i = 0; i < 8; ++i) if (!cont || i >= 4) { const int p = tid + 512 * i, row = p >> 4, c16 = p & 15; const int tk = ((n - 1) * 128 + row) * dil + res; const bool ok = (n > 0 || row >= 128);
        const size_t off = (tokbase + (ok ? tk : 0)) * 1536 + colbase + c16 * 8;
        const u32x4 kk = *(const u32x4*)(kb + off), vv = *(const u32x4*)(vb + off);
        R.k[i] = ok ? kk : (u32x4){0u, 0u, 0u, 0u}; R.v[i] = ok ? vv : (u32x4){0u, 0u, 0u, 0u}; }
    const int qtok = (n * 128 + 16 * w + fr) * dil + res;
#pragma unroll
    for (int kk = 0; kk < 4; ++kk) R.q[kk] = *(const bf16x8*)(qb + (tokbase + qtok) * 1536 + colbase + 32 * kk + 8 * fq);
}
__device__ __forceinline__ void dil_stage(const DilRegs& R, LAS unsigned char* L, int tid, int flip, int cont) {
    LAS unsigned char* Ks = L; LAS unsigned char* Vt = L + DIL_VT_OFF;
#pragma unroll
    for (int i = 0; i < 8; ++i) if (!cont || i >= 4) { const int p = tid + 512 * i, row = (p >> 4) ^ flip, c16 = p & 15;
        *(LAS u32x4*)(Ks + row * KSTR + c16 * 16) = R.k[i];
        const u32x4 v = R.v[i]; LAS unsigned char* d = Vt + (c16 * 8) * VSTR + ((row ^ (c16 << 2)) * 2);
        *(LAS unsigned short*)(d + 0 * VSTR) = (unsigned short)(v.x & 0xffffu); *(LAS unsigned short*)(d + 1 * VSTR) = (unsigned short)(v.x >> 16);
        *(LAS unsigned short*)(d + 2 * VSTR) = (unsigned short)(v.y & 0xffffu); *(LAS unsigned short*)(d + 3 * VSTR) = (unsigned short)(v.y >> 16);
        *(LAS unsigned short*)(d + 4 * VSTR) = (unsigned short)(v.z & 0xffffu); *(LAS unsigned short*)(d + 5 * VSTR) = (unsigned short)(v.z >> 16);
        *(LAS unsigned short*)(d + 6 * VSTR) = (unsigned short)(v.w & 0xffffu); *(LAS unsigned short*)(d + 7 * VSTR) = (unsigned short)(v.w >> 16); }
}
__device__ __forceinline__ void dil_compute(int it, const bf16x8 (&qf)[4], bf16* og, float* lse, LAS unsigned char* L, int tid, int flip) {
    const int lane = tid & 63, w = __builtin_amdgcn_readfirstlane(tid >> 6), fr = lane & 15, fq = lane >> 4;
    const int b = it / 768; int r = it % 768; const int g = r >> 8; r &= 255; const int h = r >> 6, blk = r & 63;
    const int dl = 2 * g, dil = 1 << dl, res = blk & (dil - 1), n = blk >> dl;
    const size_t tokbase = (size_t)b * SEQ;
    LAS unsigned char* Ks = L; LAS unsigned char* Vt = L + DIL_VT_OFF;
    const int qtok = (n * 128 + 16 * w + fr) * dil + res;
    f32x4 s[9];
#pragma unroll
    for (int bb = 0; bb < 9; ++bb) { s[bb] = (f32x4){0.f, 0.f, 0.f, 0.f};
#pragma unroll
        for (int kk = 0; kk < 4; ++kk) { const bf16x8 kf = *(const LAS bf16x8*)(Ks + ((16 * (w + bb) + fr) ^ flip) * KSTR + (32 * kk + 8 * fq) * 2);
            s[bb] = __builtin_amdgcn_mfma_f32_16x16x32_bf16(kf, qf[kk], s[bb], 0, 0, 0); } }
    const int qi = 16 * w + fr; float mx = -INFINITY;
#pragma unroll
    for (int bb = 0; bb < 9; ++bb)
#pragma unroll
        for (int i = 0; i < 4; ++i) { const int j = 16 * (w + bb) + 4 * fq + i; const bool ok = (j >= qi) && (j <= qi + 128) && (n > 0 || j >= 128);
            s[bb][i] = ok ? s[bb][i] : -INFINITY; mx = fmaxf(mx, s[bb][i]); }
    mx = fmaxf(mx, shx(mx, 16, lane)); mx = fmaxf(mx, shx(mx, 32, lane));
    float sum = 0.f;
#pragma unroll
    for (int bb = 0; bb < 9; ++bb)
#pragma unroll
        for (int i = 0; i < 4; ++i) { const float p = __builtin_amdgcn_exp2f(s[bb][i] - mx); s[bb][i] = p; sum += p; }
    sum += shx(sum, 16, lane); sum += shx(sum, 32, lane);
    f32x4 o[8];
#pragma unroll
    for (int db = 0; db < 8; ++db) o[db] = (f32x4){0.f, 0.f, 0.f, 0.f};
#pragma unroll
    for (int pr = 0; pr < 5; ++pr) { const int bA = pr < 4 ? 2 * pr : 7, bB = pr < 4 ? 2 * pr + 1 : 8;
        u32x4 pw; pw.x = pr < 4 ? cvt_pk_bf16(s[bA][0], s[bA][1]) : 0u; pw.y = pr < 4 ? cvt_pk_bf16(s[bA][2], s[bA][3]) : 0u; pw.z = cvt_pk_bf16(s[bB][0], s[bB][1]); pw.w = cvt_pk_bf16(s[bB][2], s[bB][3]);
        const bf16x8 pf = __builtin_bit_cast(bf16x8, pw);
#pragma unroll
        for (int db = 0; db < 8; ++db) { const LAS unsigned char* vr = Vt + (16 * db + fr) * VSTR;
            const int swz = (((2 * db + (fr >> 3)) & 15) << 2) ^ flip;
            const u32x2 va = *(const LAS u32x2*)(vr + ((16 * (w + bA) + 4 * fq) ^ swz) * 2), vc = *(const LAS u32x2*)(vr + ((16 * (w + bB) + 4 * fq) ^ swz) * 2);
            u32x4 vv; vv.x = va.x; vv.y = va.y; vv.z = vc.x; vv.w = vc.y;
            o[db] = __builtin_amdgcn_mfma_f32_16x16x32_bf16(__builtin_bit_cast(bf16x8, vv), pf, o[db], 0, 0, 0); } }
    const float inv = 1.0f / sum; const size_t orow = (size_t)g * M + tokbase + qtok;
#pragma unroll
    for (int db = 0; db < 8; ++db) { u32x2 w2; w2.x = cvt_pk_bf16(o[db][0] * inv, o[db][1] * inv); w2.y = cvt_pk_bf16(o[db][2] * inv, o[db][3] * inv);
        *(u32x2*)(og + orow * 512 + h * 128 + 16 * db + 4 * fq) = w2; }
    if (fq == 0) lse[orow * 4 + h] = (mx + __builtin_amdgcn_logf(sum)) * 0.6931471805599453f;
}

#define Wt_in ((bf16*)(ws + WS_WIN))
#define Wt_bra ((bf16*)(ws + WS_WBRA))
#define Wt_brb ((bf16*)(ws + WS_WBRB))
#define Wt_brc ((bf16*)(ws + WS_WBRC))
#define Wt_glu ((bf16*)(ws + WS_WGLU))
#define Wt_out ((bf16*)(ws + WS_WOUT))
#define Wt_up ((bf16*)(ws + WS_WUP))
#define Wt_down ((bf16*)(ws + WS_WDOWN))
#define Wt_s1 ((bf16*)(ws + WS_WS1))
#define Wt_s2 ((bf16*)(ws + WS_WS2))
#define L32 ((float*)(ws + WS_L32))
#define ropeA ((float*)(ws + WS_ROPEA))
#define ropeB ((float*)(ws + WS_ROPEB))
#define X ((float*)(ws + WS_X))
#define H ((bf16*)(ws + WS_H))
#define QA ((bf16*)(ws + WS_QA))
#define KA ((bf16*)(ws + WS_KA))
#define VA ((bf16*)(ws + WS_VA))
#define QB ((bf16*)(ws + WS_QB))
#define KB ((bf16*)(ws + WS_KB))
#define VB ((bf16*)(ws + WS_VB))
#define CU ((bf16*)(ws + WS_CU))
#define GATES ((bf16*)(ws + WS_GATES))
#define O16 ((bf16*)(ws + WS_O16))
#define OG ((bf16*)(ws + WS_OG))
#define LSE ((float*)(ws + WS_LSE))
#define OA ((bf16*)(ws + WS_OA))
#define OABC ((bf16*)(ws + WS_QB))
#define SSQ ((float*)(ws + WS_SSQ))
#define Y ((bf16*)(ws + WS_Y))
#define EB ((float*)(ws + WS_E))
#define CARRY ((bf16*)(ws + WS_CARRY))
#define Z ((bf16*)(ws + WS_Z))
#define OC ((bf16*)(ws + WS_OC))
#define OB ((bf16*)(ws + WS_OB))
#define MF ((float*)(ws + WS_MF))
#define MB ((bf16*)(ws + WS_MB))
#define FA ((bf16*)(ws + WS_FA))
#define FB ((bf16*)(ws + WS_FB))
#define ACT ((bf16*)(ws + WS_ACT))
__device__ __forceinline__ void scan_item(int b, int g, int pg, int lane, const float* L32_, const float* EB_, bf16* CARRY_) {
    const int p = pg * 4 + (lane & 3), seg = lane >> 2;
    const float lr = L32_[(g * 64 + p) * 2], li = L32_[(g * 64 + p) * 2 + 1];
    float er[16], ei[16];
#pragma unroll
    for (int j = 0; j < 16; ++j) { const float* e = EB_ + ((size_t)g * 512 + b * 256 + seg * 16 + j) * 128 + p; er[j] = e[0]; ei[j] = e[64]; }
    float sr = 0.f, si = 0.f;
#pragma unroll
    for (int j = 0; j < 16; ++j) { const float nr = lr * sr - li * si + er[j], ni = lr * si + li * sr + ei[j]; sr = nr; si = ni; }
    float pr = lr, pi = li;
#pragma unroll
    for (int q = 0; q < 4; ++q) { const float nr = pr * pr - pi * pi, ni = 2.f * pr * pi; pr = nr; pi = ni; }
#pragma unroll
    for (int d = 1; d < 16; d <<= 1) {
        const int src = (lane - 4 * d) & 63;
        const float qr = __int_as_float(__builtin_amdgcn_ds_bpermute(src << 2, __float_as_int(sr))), qi = __int_as_float(__builtin_amdgcn_ds_bpermute(src << 2, __float_as_int(si)));
        if (seg >= d) { sr += pr * qr - pi * qi; si += pr * qi + pi * qr; }
        const float nr = pr * pr - pi * pi, ni = 2.f * pr * pi; pr = nr; pi = ni;
    }
    float cr = __int_as_float(__builtin_amdgcn_ds_bpermute(((lane - 4) & 63) << 2, __float_as_int(sr))), ci = __int_as_float(__builtin_amdgcn_ds_bpermute(((lane - 4) & 63) << 2, __float_as_int(si)));
    if (seg == 0) { cr = 0.f; ci = 0.f; }
#pragma unroll
    for (int j = 0; j < 16; ++j) { bf16* c = CARRY_ + ((size_t)g * 512 + b * 256 + seg * 16 + j) * 128 + p;
        c[0] = (bf16)(cvt_pk_bf16(cr, 0.f) & 0xffffu); c[64] = (bf16)(cvt_pk_bf16(ci, 0.f) & 0xffffu);
        const float nr = lr * cr - li * ci + er[j], ni = lr * ci + li * cr + ei[j]; cr = nr; ci = ni; }
}
#define CONV_EARLY(LL, GWX, NGWX) CONV_EARLY_R(LL, GWX, NGWX, 0, 1 << 30)
#define CONV_EARLY_R(LL, GWX, NGWX, IT0, IT1) do { LAS float* scr = (LAS float*)(L + wave * 16384); \
        constexpr int I_IN = 16 * 304, I_BR = 8 * 32, I_GLU = 8 * 16, I_OUT = 16 * 32; constexpr int NIT = I_IN + 3 * I_BR + I_GLU + I_OUT; \
        for (int it = (IT0) + (GWX); it < NIT && it < (IT1); it += (NGWX)) { int r = it; \
            if (r < I_IN) { transpose_item(INF(3) + (size_t)(LL) * 1024 * INC, 1024, INC, Wt_in, 1, scr, r, lane); continue; } r -= I_IN; \
            if (r < I_BR) { transpose_item(INF(12) + (size_t)(LL) * 512 * 1024, 512, 1024, Wt_bra, 0, scr, r, lane, 1536, 0); continue; } r -= I_BR; \
            if (r < I_BR) { transpose_item(INF(15) + (size_t)(LL) * 512 * 1024, 512, 1024, Wt_bra, 0, scr, r, lane, 1536, 512); continue; } r -= I_BR; \
            if (r < I_BR) { transpose_item(INF(26) + (size_t)(LL) * 512 * 1024, 512, 1024, Wt_bra, 0, scr, r, lane, 1536, 1024); continue; } r -= I_BR; \
            if (r < I_GLU) { transpose_item(INF(24) + (size_t)(LL) * 512 * 512, 512, 512, Wt_glu, 0, scr, r, lane); continue; } r -= I_GLU; \
            transpose_item(INF(27) + (size_t)(LL) * 1024 * 1024, 1024, 1024, Wt_out, 0, scr, r, lane); } } while (0)
#define CONV_LATE(LL, GWX, NGWX) do { LAS float* scr = (LAS float*)(L + wave * 16384); \
        constexpr int I_UP = 16 * 176, I_DOWN = 44 * 32; \
        for (int it = (GWX); it < I_UP + I_DOWN; it += (NGWX)) { \
            if (it < I_UP) transpose_item(INF(29) + (size_t)(LL) * 1024 * 2 * DFF, 1024, 2 * DFF, Wt_up, 2, scr, it, lane); \
            else transpose_item(INF(32) + (size_t)(LL) * DFF * 1024, DFF, 1024, Wt_down, 0, scr, it - I_UP, lane); } } while (0)
#define SSM_BUILD(LL, GG, HH) ssm_build((GG), INF(16) + (LL) * 2048, INF(17) + (LL) * 2048, INF(18) + (LL) * 32, INF(19) + (size_t)(LL) * 32768, INF(20) + (size_t)(LL) * 32768, INF(21) + (size_t)(LL) * 32768, INF(22) + (size_t)(LL) * 32768, Wt_s1, Wt_s2, L32, (LAS float*)L, tid, (HH))
__global__ void __launch_bounds__(NWAVES * 64, 2) fwd(Args args) {
    extern __shared__ __attribute__((aligned(16))) unsigned char lds[];
    cg::grid_group grid = cg::this_grid();
    LAS unsigned char* L = (LAS unsigned char*)lds;
#if USE_XBAR
    if (threadIdx.x < 2) ((volatile LAS unsigned*)(L + XBST_OFF))[threadIdx.x] = 0u;
    __syncthreads();
    (void)xcd_barrier_post((unsigned*)(args.ws + WS_CTL), (volatile LAS unsigned*)(L + XBST_OFF));
    grid.sync();
#endif
#define INF(k) ((const float*)args.in[(k) + zz])
    for (int it2 = args.ph_lo * 2; it2 < args.ph_hi * 2; ++it2) {
        const int ph = it2 >> 1; const int l = ph / NPH, k = ph % NPH;
        if ((it2 & 1) && !((RPT >> k) & 1)) continue;
        int zz; asm volatile("s_mov_b32 %0, 0" : "=s"(zz));
        unsigned char* const ws = args.ws + zz;
        const int G = (int)gridDim.x + zz, bx = (int)blockIdx.x + zz, vcu = (G % 8 == 0) ? (bx % 8) * (G / 8) + bx / 8 : bx; const int NGW = G * NWAVES;
#define PHASE_IDS int tid = threadIdx.x; asm volatile("" : "+v"(tid)); const int lane = tid & 63, wave = __builtin_amdgcn_readfirstlane(tid >> 6); const int gw = vcu * NWAVES + wave; (void)lane; (void)gw;
        const float* xin = (l == 0) ? INF(0) : X;
        if (k == 0 && l == 0 && (PHMASK & 1)) {
            PHASE_IDS
            if (vcu < 64) SSM_BUILD(0, vcu >> 1, vcu & 1);
            CONV_EARLY(0, gw, NGW);
            if (l == 0) {
                const int* pos = (const int*)args.in[1 + zz];
                for (int idx = (vcu * 512 + tid); idx < M * 8; idx += G * 512) { const int m = idx >> 3, i = idx & 7; const float inv = expf(-(float)(2 * i) / 16.0f * 13.122363377404328f);
                    float s, c; sincosf((float)pos[m] * inv, &s, &c); ropeA[idx * 2] = c; ropeA[idx * 2 + 1] = s; }
                for (int idx = (vcu * 512 + tid); idx < M * 16; idx += G * 512) { const int m = idx >> 4, i = idx & 15; const float inv = expf(-(float)(2 * i) / 32.0f * 13.122363377404328f);
                    float s, c; sincosf((float)pos[m] * inv, &s, &c); ropeB[idx * 2] = c; ropeB[idx * 2 + 1] = s; }
            }
            if (l == 0) for (int m = gw; m < M; m += NGW) rms_row(xin + (size_t)m * 1024, INF(2) + l * 1024, H + (size_t)m * 1024, SSQ + (size_t)m * 4, lane);
        } else if (k == 1 && (PHMASK & (1 << 1))) {
            pg8::Gemm g{(const char*)H, (const char*)Wt_in, 1024, 2048, 32, 128};
            pg8::StaticOrder S; S.init(M, INC, G, bx, (size_t)256 * 2048, (size_t)256 * 1024 * 2);
            pg8::EpiInProj E{QA, KA, VA, QB, KB, VB, CU, GATES, INF(5) + l * 64, INF(6) + l * 64, INF(13) + l * 128, INF(14) + l * 128, INF(4) + l * 3072, ropeA, ropeB, (LAS float*)(L + XCH_OFF), SSQ};
            pg8::gemm_phase<pg8::EpiInProj, pg8::StaticOrder, true, true>(L, g, S, E);
            if (bx >= 128) { PHASE_IDS for (int rep_ = 0; rep_ <= CONVREP; ++rep_) CONV_LATE(l, (bx - 128) * NWAVES + wave, 128 * NWAVES); }
        } else if (k == 2 && (PHMASK & (1 << 2))) {
            PHASE_IDS
            {
                const attn_body::AttnTensors AT{(const attn_body::bf16*)QA, (const attn_body::bf16*)KA, (const attn_body::bf16*)VA, (attn_body::bf16*)O16};
                const attn_body::StaticOrder S(G, bx);
                for (int rep_ = 0; rep_ <= ATTREP; ++rep_) attn_body::attn_phase<attn_body::StaticOrder>((char*)lds, AT, S);
            }
            __syncthreads();
            for (int rep = 0; rep <= DILREP; ++rep) {
                const bool clsA = vcu >= 192, clsB = !clsA && (vcu % 3) == 2;
                const int pbase = clsA ? 384 + (vcu - 192) : (clsB ? 640 + vcu / 3 : (vcu / 3) * 2 + (vcu % 3)), pstep = (clsA || clsB) ? 64 : 128, nitem = clsA ? 8 : (clsB ? 4 : 6);
#define DIL_ITEM(s, IT) do { const int pid_ = pbase + ((s) >> 1) * pstep, b_ = pid_ / 384, r_ = pid_ % 384, g_ = r_ >> 7, h_ = (r_ >> 5) & 3, pb_ = r_ & 31, dl_ = 2 * g_; \
        IT = b_ * 768 + g_ * 256 + h_ * 64 + ((((pb_ >> dl_) * 2 + ((s) & 1)) << dl_) | (pb_ & ((1 << dl_) - 1))); } while (0)
                int it0_; DIL_ITEM(0, it0_);
                DilRegs R; dil_load(it0_, QB, KB, VB, R, tid, 0);
                for (int s = 0; s < nitem; ++s) {
                    int it; DIL_ITEM(s, it); const int cont = s & 1, flip = cont ? 128 : 0;
                    dil_stage(R, L, tid, flip, cont);
                    bf16x8 qf[4];
#pragma unroll
                    for (int kk = 0; kk < 4; ++kk) qf[kk] = R.q[kk];
                    __syncthreads();
                    if (s + 1 < nitem) { int itn; DIL_ITEM(s + 1, itn); dil_load(itn, QB, KB, VB, R, tid, (s + 1) & 1); }
                    dil_compute(it, qf, OG, LSE, L, tid, flip);
                    __syncthreads();
                }
            }
            {
                pg8::Gemm g{(const char*)CU, (const char*)Wt_s1, 512, 1024, 32, 128};
                pg8::GroupOrder S; S.init(2, 3, G, vcu, (size_t)256 * 1024, (size_t)256 * 512 * 2, (size_t)16384 * 16 * 2, (size_t)768 * 512 * 2);
                pg8::EpiSsm1 E{Y, EB};
                pg8::gemm_phase<pg8::EpiSsm1, pg8::GroupOrder, true, true>(L, g, S, E);
                if (vcu < 192 && (vcu % 3) == 2) {
                    asm volatile("s_waitcnt vmcnt(0)" ::: "memory"); __syncthreads();
                    for (int pg = wave; pg < 16; pg += NWAVES) scan_item((vcu % 6) / 3, vcu / 6, pg, lane, L32, EB, CARRY);
                }
            }
        } else if (k == 3 && (PHMASK & (1 << 3))) {
            PHASE_IDS
            {
                const float lam_init = 0.8f - 0.6f * expf(-0.3f * (float)l);
                const float d1 = wave_sum(INF(7)[l * 64 + lane] * INF(8)[l * 64 + lane], lane), d2 = wave_sum(INF(9)[l * 64 + lane] * INF(10)[l * 64 + lane], lane);
                const float lam = expf(d1) - expf(d2) + lam_init;
                const int head = lane >> 4, e8 = (lane & 15) * 8;
                f32x4 sg0 = *(const f32x4*)(INF(11) + l * 128 + e8), sg1 = *(const f32x4*)(INF(11) + l * 128 + e8 + 4);
                sg0 *= (1.0f - lam_init); sg1 *= (1.0f - lam_init);
                const int CSPLIT = 4864;
                const int half_ = (bx < 128) ? 0 : 1, gwh = (bx & 127) * NWAVES + wave;
                for (int m = (half_ ? CSPLIT : 0) + gwh; m < (half_ ? M : CSPLIT); m += 128 * NWAVES) {
                    f32x4 a0, a1, b0, b1; unpack8(*(const u32x4*)(O16 + (size_t)m * 1024 + head * 256 + e8), a0, a1); unpack8(*(const u32x4*)(O16 + (size_t)m * 1024 + head * 256 + 128 + e8), b0, b1);
                    a0 -= lam * b0; a1 -= lam * b1;
                    float ss = 0.f;
#pragma unroll
                    for (int e = 0; e < 4; ++e) ss += a0[e] * a0[e] + a1[e] * a1[e];
                    ss += shx(ss, 1, lane); ss += shx(ss, 2, lane); ss += shx(ss, 4, lane); ss += shx(ss, 8, lane);
                    const float rs = __builtin_amdgcn_rsqf(ss * (1.0f / 128.0f) + 1e-6f);
                    *(u32x4*)(OABC + (size_t)m * 1536 + head * 128 + e8) = pack8(a0 * rs * sg0, a1 * rs * sg1);
                    const float l0 = LSE[((size_t)0 * M + m) * 4 + head], l1 = LSE[((size_t)1 * M + m) * 4 + head], l2 = LSE[((size_t)2 * M + m) * 4 + head];
                    const float lm = fmaxf(l0, fmaxf(l1, l2)); const float w0 = __expf(l0 - lm), w1 = __expf(l1 - lm), w2 = __expf(l2 - lm); const float wi = 1.0f / (w0 + w1 + w2);
                    f32x4 p0, p1, q0, q1, r0, r1;
                    unpack8(*(const u32x4*)(OG + ((size_t)0 * M + m) * 512 + head * 128 + e8), p0, p1); unpack8(*(const u32x4*)(OG + ((size_t)1 * M + m) * 512 + head * 128 + e8), q0, q1);
                    unpack8(*(const u32x4*)(OG + ((size_t)2 * M + m) * 512 + head * 128 + e8), r0, r1);
                    p0 = (p0 * w0 + q0 * w1 + r0 * w2) * wi; p1 = (p1 * w0 + q1 * w1 + r1 * w2) * wi;
                    *(u32x4*)(OABC + (size_t)m * 1536 + 512 + head * 128 + e8) = pack8(p0, p1);
                }
            }
            {
                pg8::Gemm g{(const char*)CARRY, (const char*)Wt_s2, 128, 256, 32, 128};
                pg8::GroupOrder S; S.init(2, 2, G, bx, (size_t)256 * 256, (size_t)256 * 128 * 2, (size_t)512 * 128 * 2, (size_t)512 * 128 * 2);
                pg8::EpiSsm2 E{Y, CU, INF(23) + l * 512, Z};
                pg8::gemm_phase<pg8::EpiSsm2, pg8::GroupOrder, true, true>(L, g, S, E);
            }
        } else if (k == 4 && (PHMASK & (1 << 4))) {
            pg8::Gemm g{(const char*)CARRY, (const char*)Wt_s2, 128, 8192, 32, 128};
            pg8::GroupOrder S; S.init(2, 2, G, bx, (size_t)256 * 8192, (size_t)256 * 128 * 2, 256, (size_t)512 * 128 * 2);
            pg8::EpiSsm2 E{Y, CU, INF(23) + l * 512, Z};
            pg8::gemm_phase<pg8::EpiSsm2, pg8::GroupOrder, true, true>(L, g, S, E);
        } else if (k == 5 && (PHMASK & (1 << 5))) {
            pg8::Gemm g{(const char*)Z, (const char*)Wt_glu, 512, 1024, 32, 128};
            pg8::StaticOrder S; S.init(M, 512, G, bx, (size_t)256 * 1024, (size_t)256 * 512 * 2);
            pg8::EpiGlu E{Z, INF(25) + l * 512, OABC + 1024, 1536};
            pg8::gemm_phase<pg8::EpiGlu, pg8::StaticOrder, true, true>(L, g, S, E);
            if (bx >= 128 && l + 1 < DEPTH) { PHASE_IDS
                if (bx < 192) SSM_BUILD(l + 1, (bx - 128) >> 1, (bx - 128) & 1); else CONV_EARLY_R(l + 1, (bx - 192) * NWAVES + wave, 64 * NWAVES, 0, 1536); }
        } else if (k == 6 && (PHMASK & (1 << 6))) {
            pg8::Gemm g{(const char*)OABC, (const char*)Wt_bra, 1536, 3072, 32, 128};
            pg8::StaticOrder S; S.init(M, 1024, G, bx, (size_t)256 * 3072, (size_t)256 * 1536 * 2);
            pg8::EpiMergeF E{GATES, MB};
            pg8::gemm_phase<pg8::EpiMergeF, pg8::StaticOrder, true, true>(L, g, S, E);
        } else if (k == 7 && (PHMASK & (1 << 7))) {
            pg8::Gemm g{(const char*)MB, (const char*)Wt_out, 1024, 2048, 32, 128};
            pg8::StaticOrder S; S.init(M, 1024, G, bx, (size_t)256 * 2048, (size_t)256 * 1024 * 2);
            if ((RPT & 0x80) && !(it2 & 1)) { pg8::EpiResid E{xin, (float*)(ws + WS_OG)}; pg8::gemm_phase<pg8::EpiResid, pg8::StaticOrder, true, true>(L, g, S, E); } else {
            pg8::EpiResidN E{xin, X, INF(28) + l * 1024, H, SSQ, (LAS float*)(L + XCH_OFF)};
            pg8::gemm_phase<pg8::EpiResidN, pg8::StaticOrder, true, true>(L, g, S, E); }
        } else if (k == 8 && (PHMASK & (1 << 8))) {
            PHASE_IDS
        } else if (k == 9 && (PHMASK & (1 << 9))) {
            pg8::Gemm g{(const char*)H - 2 * 2048, (const char*)Wt_up, 1024, 2048, 32, 128};
            pg8::StaticOrder S; S.init_tiles(65, 22, G, bx, (size_t)254 * 2048, (size_t)256 * 1024 * 2);
            pg8::EpiUpConv E{ACT, SSQ, INF(30) + (size_t)l * 3 * DFF, INF(31) + (size_t)l * DFF, (LAS float*)(L + XCH_OFF)};
            pg8::gemm_phase<pg8::EpiUpConv, pg8::StaticOrder, true, true>(L, g, S, E);
            if (bx >= 150 && l + 1 < DEPTH) { PHASE_IDS for (int rep_ = 0; rep_ <= CONVREP; ++rep_) { CONV_EARLY_R(l + 1, (bx - 150) * NWAVES + wave, 106 * NWAVES, 1536, 1 << 30); } }
        } else if (k == 10 && (PHMASK & (1 << 10))) {
            PHASE_IDS
            const float* cw = INF(30) + (size_t)l * 3 * DFF; const float* cb = INF(31) + (size_t)l * DFF;
            for (int it = vcu * 512 + tid; it < 2048 * 352; it += G * 512) {
                const int cc = it % 352, rr = it / 352, t0 = rr * 8, col = cc * 8;
                u32x4 ra[10], rb[8];
                const bool first = (t0 & (SEQ - 1)) == 0;
                ra[0] = first ? (u32x4){0u, 0u, 0u, 0u} : *(const u32x4*)(FA + (size_t)(t0 - 2) * DFF + col);
                ra[1] = first ? (u32x4){0u, 0u, 0u, 0u} : *(const u32x4*)(FA + (size_t)(t0 - 1) * DFF + col);
#pragma unroll
                for (int t = 0; t < 8; ++t) { ra[t + 2] = *(const u32x4*)(FA + (size_t)(t0 + t) * DFF + col); rb[t] = *(const u32x4*)(FB + (size_t)(t0 + t) * DFF + col); }
                const f32x4 w0a = *(const f32x4*)(cw + col), w0b = *(const f32x4*)(cw + col + 4), w1a = *(const f32x4*)(cw + DFF + col), w1b = *(const f32x4*)(cw + DFF + col + 4);
                const f32x4 w2a = *(const f32x4*)(cw + 2 * DFF + col), w2b = *(const f32x4*)(cw + 2 * DFF + col + 4), ba = *(const f32x4*)(cb + col), bb = *(const f32x4*)(cb + col + 4);
                f32x4 h2a, h2b, h1a, h1b; unpack8(ra[0], h2a, h2b); unpack8(ra[1], h1a, h1b);
#pragma unroll
                for (int t = 0; t < 8; ++t) {
                    f32x4 ca, cb2, ga, gb; unpack8(ra[t + 2], ca, cb2); unpack8(rb[t], ga, gb);
                    f32x4 va = ba + w0a * h2a + w1a * h1a + w2a * ca, vb2 = bb + w0b * h2b + w1b * h1b + w2b * cb2;
#pragma unroll
                    for (int e = 0; e < 4; ++e) { va[e] = va[e] * pg8::sigmoidf_(va[e]) * ga[e]; vb2[e] = vb2[e] * pg8::sigmoidf_(vb2[e]) * gb[e]; }
                    *(u32x4*)(ACT + (size_t)(t0 + t) * DFF + col) = pack8(va, vb2);
                    h2a = h1a; h2b = h1b; h1a = ca; h1b = cb2;
                }
            }
        } else if (k == 11 && (PHMASK & (1 << 11))) {
            pg8::Gemm g{(const char*)ACT, (const char*)Wt_down, DFF, 2 * DFF, 32, 128};
            pg8::StaticOrder S; S.init(M, 1024, G, bx, (size_t)256 * 2 * DFF, (size_t)256 * DFF * 2);
            if ((RPT & 0x800) && !(it2 & 1)) { pg8::EpiResid E{X, (float*)(ws + WS_OG)}; pg8::gemm_phase<pg8::EpiResid, pg8::StaticOrder, true, true>(L, g, S, E); }
            else if (l == DEPTH - 1) { pg8::EpiResid E{X, args.out + zz}; pg8::gemm_phase<pg8::EpiResid, pg8::StaticOrder, true, true>(L, g, S, E); }
            else { pg8::EpiResidN E{X, X, INF(2) + (l + 1) * 1024, H, SSQ, (LAS float*)(L + XCH_OFF)}; pg8::gemm_phase<pg8::EpiResidN, pg8::StaticOrder, true, true>(L, g, S, E); }
        }
        if (k == 4 || k == 8 || k == 10 || (k == 0 && l > 0)) continue;
        if (it2 + 2 < args.ph_hi * 2 || (RPT != 0 && it2 + 1 < args.ph_hi * 2)) for (int xs = 0; xs <= XSEAM; ++xs) {
#if SEAM_FENCES
            __builtin_amdgcn_fence(__ATOMIC_RELEASE, "agent"); asm volatile("s_waitcnt vmcnt(0) lgkmcnt(0)" ::: "memory");
            grid.sync();
            __builtin_amdgcn_fence(__ATOMIC_ACQUIRE, "agent"); asm volatile("s_waitcnt vmcnt(0) lgkmcnt(0)" ::: "memory");
            __syncthreads();
#elif USE_XBAR
            { XcdBarrier xb_; xb_.bar = (unsigned*)(ws + WS_CTL); xb_.x = xb_xcc_id(); xb_.st = (volatile LAS unsigned*)(L + XBST_OFF); xcd_barrier(xb_); }
#else
            grid.sync();
#endif
        }
    }
#undef INF
}

extern "C" void kernel_launch(void* const* d_in, const int* in_sizes, int n_in, void* d_out, int out_size, void* d_ws, size_t ws_size, hipStream_t stream) {
    static int grid = 0;
    if (grid == 0) {
        if (n_in != 33 || in_sizes[0] != M * DMODEL || out_size != M * DMODEL || ws_size < WS_TOTAL) { fprintf(stderr, "kernel_launch: unexpected shapes/workspace (n_in %d, ws %zu < %zu)\n", n_in, ws_size, (size_t)WS_END); grid = -1; return; }
        int dev = 0, cus = 0, per_cu = 0;
        if (hipGetDevice(&dev) != hipSuccess || hipDeviceGetAttribute(&cus, hipDeviceAttributeMultiprocessorCount, dev) != hipSuccess) { grid = -1; return; }
        if (hipFuncSetAttribute((const void*)fwd, hipFuncAttributeMaxDynamicSharedMemorySize, LDS_BYTES) != hipSuccess) { fprintf(stderr, "kernel_launch: hipFuncSetAttribute failed\n"); grid = -1; return; }
        if (hipOccupancyMaxActiveBlocksPerMultiprocessor(&per_cu, (const void*)fwd, NWAVES * 64, LDS_BYTES) != hipSuccess || per_cu < 1) per_cu = 1;
        (void)hipGetLastError();
        grid = cus;
    }
    if (grid < 0) return;
    if (hipMemsetAsync((char*)d_ws + WS_CTL, 0, CTL_BYTES, stream) != hipSuccess) { fprintf(stderr, "kernel_launch: memset of the barrier words failed\n"); return; }
    Args a{};
    for (int i = 0; i < 33; ++i) a.in[i] = d_in[i];
    a.out = (float*)d_out; a.ws = (unsigned char*)d_ws; a.ph_lo = 0; a.ph_hi = DEPTH * NPH;
    void* kargs[] = {&a};
    hipError_t e = hipLaunchCooperativeKernel((const void*)fwd, dim3(grid), dim3(NWAVES * 64), kargs, LDS_BYTES, stream);
    if (e != hipSuccess) fprintf(stderr, "kernel_launch: cooperative launch failed: %s (grid %d)\n", hipGetErrorString(e), grid);
}
```
